# Optimizing an MI355X kernel written in HIP

```python
import math
import jax, jax.numpy as jnp
from jax import lax
import numpy as np

D_MODEL = 1024
BATCH = 8
SEQ = 8192
DEPTH = 2

CTX_LEN = 256
GRID_W = 64
D_MIX = D_MODEL
N_GROUPS = 4
GROUP_W = D_MIX // N_GROUPS
D_FF = 2816
N_MOD = 9
EPS = 1e-6
ROPE_THETA = 10000.0
Q_BLOCK = 128
DA_HEADS = 4
DA_QK = GROUP_W // (2 * DA_HEADS)
DA_V = GROUP_W // DA_HEADS
POOL_WINDOWS = (2, 4, 8, 16)
POOL_GROUP = GROUP_W // len(POOL_WINDOWS)
ML_HEADS = 4
ML_DIM = GROUP_W // ML_HEADS
ML_CHUNK = 64
GQA_HEADS = 4
GQA_KV_HEADS = 2
GQA_DIM = GROUP_W // GQA_HEADS
IN_SPLITS = (GROUP_W, GROUP_W, GROUP_W,
             GROUP_W,
             GROUP_W, GROUP_W, GROUP_W, GROUP_W, 4 * ML_HEADS,
             GROUP_W, GQA_KV_HEADS * GQA_DIM, GQA_KV_HEADS * GQA_DIM)
IN_WIDTH = sum(IN_SPLITS)

kernel_name = 'hybrid_parallel_group_dit_block'


def layer_norm(x, g=None, b=None):
    xf = x.astype(jnp.float32)
    mu = xf.mean(-1, keepdims=True)
    var = jnp.square(xf - mu).mean(-1, keepdims=True)
    y = (xf - mu) * lax.rsqrt(var + EPS)
    if g is not None:
        y = y * g.astype(jnp.float32) + b.astype(jnp.float32)
    return y.astype(x.dtype)


def rms_norm(x, g):
    xf = x.astype(jnp.float32)
    y = xf * lax.rsqrt(jnp.mean(jnp.square(xf), -1, keepdims=True) + EPS) * g.astype(jnp.float32)
    return y.astype(x.dtype)


def rope_tables(row, col, dim):
    axis_dim = dim // 2
    inv = ROPE_THETA ** (-jnp.arange(0, axis_dim, 2, dtype=jnp.float32) / axis_dim)
    ang = jnp.concatenate([row.astype(jnp.float32)[:, None] * inv,
                           col.astype(jnp.float32)[:, None] * inv], axis=-1)
    return jnp.cos(ang), jnp.sin(ang)


def apply_rope(x, cos, sin):
    half = x.shape[-1] // 2
    shape = (1, cos.shape[0]) + (1,) * (x.ndim - 3) + (half,)
    cos = cos.reshape(shape).astype(x.dtype)
    sin = sin.reshape(shape).astype(x.dtype)
    x1, x2 = x[..., :half], x[..., half:]
    return jnp.concatenate([x1 * cos - x2 * sin, x2 * cos + x1 * sin], axis=-1)


def sweep_query_blocks(fn, q):
    B, L = q.shape[0], q.shape[1]
    nb = L // Q_BLOCK
    qb = jnp.moveaxis(q.reshape((B, nb, Q_BLOCK) + q.shape[2:]), 1, 0)
    out = jnp.moveaxis(lax.map(fn, qb), 0, 1)
    return out.reshape((B, L) + out.shape[3:])


def diff_attention_core(q, k, v, lam):
    s = jnp.einsum('bqhmd,bkhmd->bhmqk', q, k).astype(jnp.float32) * DA_QK ** -0.5
    p = jax.nn.softmax(s, axis=-1)
    a = p[:, :, 0] - lam * p[:, :, 1]
    return jnp.einsum('bhqk,bkhe->bqhe', a.astype(v.dtype), v)


def gqa_core(q, k, v):
    s = jnp.einsum('bqhgd,bkhd->bhgqk', q, k).astype(jnp.float32) * GQA_DIM ** -0.5
    p = jax.nn.softmax(s, axis=-1)
    return jnp.einsum('bhgqk,bkhd->bqhgd', p.astype(v.dtype), v)


def multiscale_pool(u, pool_w, pool_scale):
    B, L, _ = u.shape
    uf = u.astype(jnp.float32)
    csum = jnp.concatenate([jnp.zeros((B, 1, GROUP_W), jnp.float32), jnp.cumsum(uf, axis=1)], axis=1)
    t = jnp.arange(L)
    outs = []
    for g, w in enumerate(POOL_WINDOWS):
        lo = jnp.clip(t - w // 2, 0, L)
        hi = jnp.clip(t + w // 2, 0, L)
        sl = slice(g * POOL_GROUP, (g + 1) * POOL_GROUP)
        mean = (csum[:, hi, sl] - csum[:, lo, sl]) / (hi - lo).astype(jnp.float32)[None, :, None]
        outs.append(mean - uf[:, :, sl])
    d = jnp.stack(outs, axis=2)
    y = jnp.einsum('blgc,gce->blge', d, pool_w.astype(jnp.float32)).reshape(B, L, GROUP_W)
    return (y * pool_scale.astype(jnp.float32)).astype(u.dtype)


def mlstm_gates(cg, gate_b):
    B, T, _ = cg.shape
    g = (cg.astype(jnp.float32) + gate_b.astype(jnp.float32).reshape(-1)).reshape(B, T, 4, ML_HEADS)
    g = jnp.transpose(g, (2, 0, 3, 1))
    return (g[0], jax.nn.log_sigmoid(g[1]), g[2], jax.nn.log_sigmoid(g[3]))


def mlstm_zero_state(B):
    return (jnp.zeros((B, ML_HEADS, ML_DIM, ML_DIM), jnp.float32),
            jnp.zeros((B, ML_HEADS, ML_DIM), jnp.float32),
            jnp.zeros((B, ML_HEADS), jnp.float32))


def mlstm_state_update(k, v, li, lf, state):
    C, n, m = state
    b = jnp.cumsum(lf, axis=-1)
    b_end = b[..., -1]
    g = b_end[..., None] - b + li
    m_new = jnp.maximum(b_end + m, g.max(-1))
    wk = jnp.exp(g - m_new[..., None])
    decay = jnp.exp(b_end + m - m_new)
    kf, vf = k.astype(jnp.float32), v.astype(jnp.float32)
    C_new = decay[..., None, None] * C + jnp.einsum('bht,bthv,bthe->bhve', wk, vf, kf)
    n_new = decay[..., None] * n + jnp.einsum('bht,bthe->bhe', wk, kf)
    return (C_new, n_new, m_new)


def mlstm_chunk_output(q, k, v, li, lf, state):
    C, n, m = state
    T = q.shape[1]
    b = jnp.cumsum(lf, axis=-1)
    dmat = b[..., :, None] - b[..., None, :] + li[..., None, :]
    dmat = jnp.where(jnp.tril(jnp.ones((T, T), dtype=bool)), dmat, -jnp.inf)
    inter = b + m[..., None]
    m_t = jnp.maximum(inter, dmat.max(axis=-1))
    w_intra = jnp.exp(dmat - m_t[..., None])
    w_inter = jnp.exp(inter - m_t)
    qf = q.astype(jnp.float32) * ML_DIM ** -0.5
    kf, vf = k.astype(jnp.float32), v.astype(jnp.float32)
    a = jnp.einsum('bjhe,bkhe->bhjk', qf, kf) * w_intra
    num = jnp.einsum('bhjk,bkhv->bjhv', a, vf) + jnp.einsum('bhj,bhve,bjhe->bjhv', w_inter, C, qf)
    den = a.sum(-1) + w_inter * jnp.einsum('bhe,bjhe->bhj', n, qf)
    den = jnp.maximum(jnp.abs(den), jnp.exp(-m_t))
    return num / jnp.swapaxes(den, 1, 2)[..., None]


def mlstm_scan(q, k, v, li, lf, state):
    B, T, H, d = q.shape
    nc = T // ML_CHUNK
    def tok_chunks(a):
        return jnp.moveaxis(a.reshape((B, nc, ML_CHUNK) + a.shape[2:]), 1, 0)
    def gate_chunks(a):
        return jnp.moveaxis(a.reshape(B, H, nc, ML_CHUNK), 2, 0)
    def body(st, xs):
        qc, kc, vc, lic, lfc = xs
        h = mlstm_chunk_output(qc, kc, vc, lic, lfc, st)
        return mlstm_state_update(kc, vc, lic, lfc, st), h
    st, hs = lax.scan(body, state, (tok_chunks(q), tok_chunks(k), tok_chunks(v), gate_chunks(li), gate_chunks(lf)))
    h = jnp.moveaxis(hs, 0, 1).reshape(B, T, H, d)
    return h.astype(q.dtype), st


def mlstm_bidirectional(q, k, v, gates, st_f, st_b):
    li_f, lf_f, li_b, lf_b = gates
    hf, end_f = mlstm_scan(q, k, v, li_f, lf_f, st_f)
    hb, end_b = mlstm_scan(q[:, ::-1], k[:, ::-1], v[:, ::-1], li_b[..., ::-1], lf_b[..., ::-1], st_b)
    return hf + hb[:, ::-1], end_f, end_b


def token_mixing(h_lat, h_ctx, layer, rope_a, rope_d, w_in, w_out, diff_lambda, diff_norm_g,
                 pool_w, pool_scale, ml_gate_b, ml_norm_g, q_norm_g, k_norm_g, ctx_out):
    B, L, _ = h_lat.shape
    Lc = h_ctx.shape[1]
    G = GQA_HEADS // GQA_KV_HEADS
    offsets = np.cumsum(IN_SPLITS)[:-1].tolist()
    aq, ak, av, bu, cq, ck, cv, co, cg, dq, dk, dv = jnp.split(h_lat @ w_in, offsets, axis=-1)
    aq_c, ak_c, av_c, bu_c, cq_c, ck_c, cv_c, co_c, cg_c, dq_c, dk_c, dv_c = jnp.split(h_ctx @ w_in, offsets, axis=-1)

    lam_init = 0.8 - 0.6 * math.exp(-0.3 * layer)
    dl = diff_lambda.astype(jnp.float32)
    lam = jnp.exp(jnp.sum(dl[0] * dl[1])) - jnp.exp(jnp.sum(dl[2] * dl[3])) + lam_init
    def diff_heads(t, n):
        return t.reshape(B, n, DA_HEADS, 2, DA_QK)
    def diff_finish(o):
        n = o.shape[1]
        return (rms_norm(o, diff_norm_g.reshape(DA_HEADS, DA_V)) * (1.0 - lam_init)).reshape(B, n, GROUP_W)
    k_a_c = diff_heads(ak_c, Lc)
    v_a_c = av_c.reshape(B, Lc, DA_HEADS, DA_V)
    k_a = jnp.concatenate([k_a_c, apply_rope(diff_heads(ak, L), *rope_a)], axis=1)
    v_a = jnp.concatenate([v_a_c, av.reshape(B, L, DA_HEADS, DA_V)], axis=1)
    q_a = apply_rope(diff_heads(aq, L), *rope_a)
    a_lat = diff_finish(sweep_query_blocks(lambda qb: diff_attention_core(qb, k_a, v_a, lam), q_a))

    b_lat = multiscale_pool(bu, pool_w, pool_scale)

    def ml_heads(t, n):
        return t.reshape(B, n, ML_HEADS, ML_DIM)
    def ml_finish(h, o):
        n = h.shape[1]
        return rms_norm(h, ml_norm_g.reshape(ML_HEADS, ML_DIM)).reshape(B, n, GROUP_W) * jax.nn.sigmoid(o)
    zero = mlstm_zero_state(B)
    gates_c = mlstm_gates(cg_c, ml_gate_b)
    q_m_c, k_m_c, v_m_c = ml_heads(cq_c, Lc), ml_heads(ck_c, Lc), ml_heads(cv_c, Lc)
    if ctx_out:
        h_m_c, st_f, st_b = mlstm_bidirectional(q_m_c, k_m_c, v_m_c, gates_c, zero, zero)
    else:
        st_f = mlstm_state_update(k_m_c, v_m_c, gates_c[0], gates_c[1], zero)
        st_b = mlstm_state_update(k_m_c[:, ::-1], v_m_c[:, ::-1], gates_c[2][..., ::-1], gates_c[3][..., ::-1], zero)
    h_m, _, _ = mlstm_bidirectional(ml_heads(cq, L), ml_heads(ck, L), ml_heads(cv, L),
                                    mlstm_gates(cg, ml_gate_b), st_f, st_b)
    c_lat = ml_finish(h_m, co)

    def gq_heads(t, n):
        return rms_norm(t.reshape(B, n, GQA_KV_HEADS, G, GQA_DIM), q_norm_g)
    def gk_heads(t, n):
        return rms_norm(t.reshape(B, n, GQA_KV_HEADS, GQA_DIM), k_norm_g)
    k_d_c = gk_heads(dk_c, Lc)
    v_d_c = dv_c.reshape(B, Lc, GQA_KV_HEADS, GQA_DIM)
    k_d = jnp.concatenate([k_d_c, apply_rope(gk_heads(dk, L), *rope_d)], axis=1)
    v_d = jnp.concatenate([v_d_c, dv.reshape(B, L, GQA_KV_HEADS, GQA_DIM)], axis=1)
    q_d = apply_rope(gq_heads(dq, L), *rope_d)
    d_lat = sweep_query_blocks(lambda qb: gqa_core(qb, k_d, v_d), q_d).reshape(B, L, GROUP_W)

    out_lat = jnp.concatenate([a_lat, b_lat, c_lat, d_lat], axis=-1) @ w_out
    if not ctx_out:
        return out_lat, None
    a_c = diff_finish(diff_attention_core(diff_heads(aq_c, Lc), k_a_c, v_a_c, lam))
    b_c = multiscale_pool(bu_c, pool_w, pool_scale)
    c_c = ml_finish(h_m_c, co_c)
    d_c = gqa_core(gq_heads(dq_c, Lc), k_d_c, v_d_c).reshape(B, Lc, GROUP_W)
    out_ctx = jnp.concatenate([a_c, b_c, c_c, d_c], axis=-1) @ w_out
    return out_lat, out_ctx


def modulate(x, mod, s):
    return layer_norm(x) * (1.0 + mod[:, 3 * s + 1]) + mod[:, 3 * s]


def swiglu(h, wi, wo):
    gate, up = jnp.split(h @ wi, 2, axis=-1)
    return (jax.nn.silu(gate) * up) @ wo


def macaron_ffn(x, mod, s, wi, wo, g, b, alpha):
    h = modulate(x, mod, s)
    return layer_norm(alpha * x + 0.5 * mod[:, 3 * s + 2] * swiglu(h, wi, wo), g, b)


def setup_inputs(seed: int = 0) -> dict:
    key = jax.random.key(seed)
    ks = jax.random.split(key, 22)
    def nrm(k, shape, s):
        return jax.random.normal(k, shape, jnp.float32) * s
    beta = (8.0 * DEPTH) ** -0.25
    gate_offset = jnp.array([0.0, 3.0, 0.0, 3.0], jnp.float32)[None, :, None]
    return {
        'x': nrm(ks[0], (BATCH, SEQ, D_MODEL), 1.0),
        'c': nrm(ks[1], (BATCH, D_MODEL), 1.0),
        'ctx': nrm(ks[2], (BATCH, CTX_LEN, D_MODEL), 1.0),
        'c_ctx': nrm(ks[3], (D_MODEL,), 1.0),
        'w_ada': nrm(ks[4], (DEPTH, D_MODEL, N_MOD * D_MODEL), 0.5 * D_MODEL ** -0.5),
        'b_ada': nrm(ks[5], (DEPTH, N_MOD * D_MODEL), 0.02),
        'ln_g': 1.0 + nrm(ks[6], (DEPTH, 3, D_MODEL), 0.02),
        'ln_b': nrm(ks[7], (DEPTH, 3, D_MODEL), 0.02),
        'ffn1_wi': nrm(ks[8], (DEPTH, D_MODEL, 2 * D_FF), D_MODEL ** -0.5),
        'ffn1_wo': nrm(ks[9], (DEPTH, D_FF, D_MODEL), beta * D_FF ** -0.5),
        'ffn2_wi': nrm(ks[10], (DEPTH, D_MODEL, 2 * D_FF), D_MODEL ** -0.5),
        'ffn2_wo': nrm(ks[11], (DEPTH, D_FF, D_MODEL), beta * D_FF ** -0.5),
        'w_in': nrm(ks[12], (DEPTH, D_MODEL, IN_WIDTH), D_MODEL ** -0.5),
        'w_out': nrm(ks[13], (DEPTH, D_MIX, D_MODEL), beta * D_MIX ** -0.5),
        'diff_lambda': nrm(ks[14], (DEPTH, 4, DA_QK), 0.1),
        'diff_norm_g': 1.0 + nrm(ks[15], (DEPTH, GROUP_W), 0.02),
        'pool_w': nrm(ks[16], (DEPTH, len(POOL_WINDOWS), POOL_GROUP, POOL_GROUP), POOL_GROUP ** -0.5),
        'pool_scale': 1.0 + nrm(ks[17], (DEPTH, GROUP_W), 0.1),
        'ml_gate_b': gate_offset + nrm(ks[18], (DEPTH, 4, ML_HEADS), 0.1),
        'ml_norm_g': 1.0 + nrm(ks[19], (DEPTH, GROUP_W), 0.02),
        'gqa_qnorm_g': 1.0 + nrm(ks[20], (DEPTH, GQA_DIM), 0.02),
        'gqa_knorm_g': 1.0 + nrm(ks[21], (DEPTH, GQA_DIM), 0.02),
    }


def reference(x, c, ctx, c_ctx, w_ada, b_ada, ln_g, ln_b, ffn1_wi, ffn1_wo, ffn2_wi, ffn2_wo,
              w_in, w_out, diff_lambda, diff_norm_g, pool_w, pool_scale, ml_gate_b, ml_norm_g,
              gqa_qnorm_g, gqa_knorm_g):
    B, L, _ = x.shape
    rows = L // GRID_W
    row = jnp.repeat(jnp.arange(rows), GRID_W)
    col = jnp.tile(jnp.arange(GRID_W), rows)
    rope_a = rope_tables(row, col, DA_QK)
    rope_d = rope_tables(row, col, GQA_DIM)
    alpha = (2.0 * DEPTH) ** 0.25
    x_ctx = ctx
    for l in range(DEPTH):
        last = l == DEPTH - 1
        mod_l = (jax.nn.silu(c) @ w_ada[l] + b_ada[l]).reshape(B, N_MOD, 1, D_MODEL)
        mod_c = (jax.nn.silu(c_ctx)[None] @ w_ada[l] + b_ada[l]).reshape(1, N_MOD, 1, D_MODEL)
        x = macaron_ffn(x, mod_l, 0, ffn1_wi[l], ffn1_wo[l], ln_g[l, 0], ln_b[l, 0], alpha)
        x_ctx = macaron_ffn(x_ctx, mod_c, 0, ffn1_wi[l], ffn1_wo[l], ln_g[l, 0], ln_b[l, 0], alpha)
        o_lat, o_ctx = token_mixing(modulate(x, mod_l, 1), modulate(x_ctx, mod_c, 1), l, rope_a, rope_d,
                                    w_in[l], w_out[l], diff_lambda[l], diff_norm_g[l], pool_w[l],
                                    pool_scale[l], ml_gate_b[l], ml_norm_g[l], gqa_qnorm_g[l],
                                    gqa_knorm_g[l], not last)
        x = layer_norm(alpha * x + mod_l[:, 5] * o_lat, ln_g[l, 1], ln_b[l, 1])
        if not last:
            x_ctx = layer_norm(alpha * x_ctx + mod_c[:, 5] * o_ctx, ln_g[l, 1], ln_b[l, 1])
            x_ctx = macaron_ffn(x_ctx, mod_c, 2, ffn2_wi[l], ffn2_wo[l], ln_g[l, 2], ln_b[l, 2], alpha)
        x = macaron_ffn(x, mod_l, 2, ffn2_wi[l], ffn2_wo[l], ln_g[l, 2], ln_b[l, 2], alpha)
    return x
```

```cpp
#include <hip/hip_runtime.h>
#include <hip/hip_cooperative_groups.h>
#include <cstdio>
#include <cstdint>
#include <cstring>
namespace cg = cooperative_groups;

#ifndef MK_SPLIT
#define MK_SPLIT 0
#endif

typedef unsigned short bf16_t;
typedef short bf16x8 __attribute__((ext_vector_type(8)));
typedef short s16x4 __attribute__((ext_vector_type(4)));
typedef float f32x16 __attribute__((ext_vector_type(16)));
typedef float f32x2 __attribute__((ext_vector_type(2)));
typedef __bf16 bf16v2 __attribute__((ext_vector_type(2)));
typedef unsigned u32x4 __attribute__((ext_vector_type(4)));
typedef unsigned u32x2 __attribute__((ext_vector_type(2)));

#define DI __device__ __forceinline__
#define MFMA32(a, b, c) __builtin_amdgcn_mfma_f32_32x32x16_bf16((a), (b), (c), 0, 0, 0)

constexpr int DM = 1024, NB = 8, SEQL = 8192, CTXL = 256, DFF = 2816;
constexpr int NL = NB * SEQL;
constexpr int NC = NB * CTXL;
constexpr int NT = NL + NC;
constexpr int NKEY = SEQL + CTXL;
constexpr int PW = 2560;
constexpr int PWP = 2816;
constexpr int NCH = 132;
constexpr int STSZ = 4160;
constexpr float EPSV = 1e-6f;
constexpr float ALPHA = 1.4142135623730951f;
constexpr int THREADS = 256;
constexpr int WG_THREADS = 512;
constexpr int HALF_LDS = 73728;
constexpr int LDS_BYTES = 2 * HALF_LDS + 4096;

struct Params {
    const float *x, *c, *ctx, *c_ctx, *w_ada, *b_ada, *ln_g, *ln_b, *ffn1_wi, *ffn1_wo, *ffn2_wi, *ffn2_wo, *w_in, *w_out,
        *diff_lambda, *diff_norm_g, *pool_w, *pool_scale, *ml_gate_b, *ml_norm_g, *qng, *kng;
    float* XL;
    float* XC;
    bf16_t* WB;
    float* MOD;
    float* ROPEA;
    float* ROPED;
    float* LAM;
    bf16_t* H;
    bf16_t* ACT;
    float* GATES;
    bf16_t *KA, *VTA, *KD, *VTD;
    bf16_t* ST;
    float* DEC;
    unsigned* SYNC;
    unsigned* XBAR;
    float* STATS;
};

constexpr size_t W_WI1 = 0, W_WO1 = W_WI1 + (size_t)5632 * 1024, W_WI2 = W_WO1 + (size_t)1024 * 2816, W_WO2 = W_WI2 + (size_t)5632 * 1024,
                 W_WIN = W_WO2 + (size_t)1024 * 2816, W_WOUT = W_WIN + (size_t)PWP * 1024, W_LAYER = W_WOUT + (size_t)1024 * 1024;

DI unsigned pk_bf16(float a, float b) { f32x2 v = {a, b}; bf16v2 r = __builtin_convertvector(v, bf16v2); return __builtin_bit_cast(unsigned, r); }
DI bf16_t to_bf16(float a) { return (bf16_t)(pk_bf16(a, 0.f) & 0xffffu); }
DI float bf2f(unsigned short x) { return __uint_as_float(((unsigned)x) << 16); }
DI float bflo(unsigned w) { return __uint_as_float(w << 16); }
DI float bfhi(unsigned w) { return __uint_as_float(w & 0xffff0000u); }
DI int otid() { int t = threadIdx.x & 255; asm volatile("" : "+v"(t)); return t; }
DI int otid512() { int t = threadIdx.x; asm volatile("" : "+v"(t)); return t; }
DI int ohalf() { int t = __builtin_amdgcn_readfirstlane(threadIdx.x >> 8); asm volatile("" : "+s"(t)); return t; }
DI int obid() { int t = blockIdx.x * 2 + __builtin_amdgcn_readfirstlane(threadIdx.x >> 8); asm volatile("" : "+s"(t)); return t; }
DI int ogrid() { int t = gridDim.x * 2; asm volatile("" : "+s"(t)); return t; }
DI int rbid() { int t = blockIdx.x; asm volatile("" : "+s"(t)); return t; }
DI int rgrid() { int t = gridDim.x; asm volatile("" : "+s"(t)); return t; }
DI int crow(int i, int h) { return (i & 3) + 8 * (i >> 2) + 4 * h; }
DI float shx(float v, int lane, int m) { return __int_as_float(__builtin_amdgcn_ds_bpermute((lane ^ m) << 2, __float_as_int(v))); }
DI float shl(float v, int src_lane) { return __int_as_float(__builtin_amdgcn_ds_bpermute(src_lane << 2, __float_as_int(v))); }
DI float wave_sum(float v, int lane) {
#pragma unroll
    for (int o = 32; o > 0; o >>= 1) v += shx(v, lane, o);
    return v;
}
DI void unpack8(u32x4 w, float* f) {
    f[0] = bflo(w.x); f[1] = bfhi(w.x); f[2] = bflo(w.y); f[3] = bfhi(w.y); f[4] = bflo(w.z); f[5] = bfhi(w.z); f[6] = bflo(w.w); f[7] = bfhi(w.w);
}
DI u32x4 pack8(const float* f) { u32x4 w; w.x = pk_bf16(f[0], f[1]); w.y = pk_bf16(f[2], f[3]); w.z = pk_bf16(f[4], f[5]); w.w = pk_bf16(f[6], f[7]); return w; }
DI float* xrow_ptr(const Params& p, int row) { return row < NL ? p.XL + (size_t)row * DM : p.XC + (size_t)(row - NL) * DM; }

#define XB_TMO      128
#define XB_XCNT(j)  (256  + 64 * (j))
#define XB_XSUB(j)  (1280 + 64 * (j))
#define XB_XGEN(j)  (2304 + 64 * (j))
#define XB_TOP      3328
#define XB_TOPGEN   3392
#define XCD_BAR_WORDS 3456
#define XB_SPIN_CAP (1u << 18)
#define XB_LAS __attribute__((address_space(3)))

__device__ __forceinline__ unsigned xb_ld(unsigned* p)              { return __hip_atomic_load(p, __ATOMIC_RELAXED, __HIP_MEMORY_SCOPE_AGENT); }
__device__ __forceinline__ unsigned xb_add(unsigned* p, unsigned v) { return __hip_atomic_fetch_add(p, v, __ATOMIC_RELAXED, __HIP_MEMORY_SCOPE_AGENT); }
__device__ __forceinline__ unsigned xb_xcc_id() { return (unsigned)__builtin_amdgcn_s_getreg((3 << 11) | 20) & 0xFu; }
#define XB_SPIN(cond, bar) do { unsigned _sp = 0; while (cond) { __builtin_amdgcn_s_sleep(1); \
    if ((++_sp & 255u) == 0u) { if (xb_ld(&(bar)[XB_TMO])) break; if (_sp > XB_SPIN_CAP) { atomicAdd(&(bar)[XB_TMO], 1u); break; } } } } while (0)

struct XcdBarrier {
    unsigned* bar; unsigned x;
    volatile XB_LAS unsigned* st;
};

__device__ __forceinline__ XcdBarrier xcd_barrier_post(unsigned* bar, volatile XB_LAS unsigned* st) {
    XcdBarrier b; b.bar = bar; b.x = xb_xcc_id(); b.st = st;
    if (threadIdx.x == 0) (void)xb_add(&bar[XB_XCNT(b.x)], 1u);
    return b;
}
__device__ __forceinline__ void xcd_barrier_complete(unsigned* bar, unsigned x, unsigned& nloc, unsigned& nx) {
    const unsigned G = gridDim.x * gridDim.y * gridDim.z;
    unsigned sum, cnt, mine, sp = 0u;
    for (;;) {
        sum = 0u; cnt = 0u; mine = 0u;
#pragma unroll
        for (unsigned j = 0; j < 16; ++j) { const unsigned c = xb_ld(&bar[XB_XCNT(j)]); sum += c; cnt += (c > 0u) ? 1u : 0u; mine = (j == x) ? c : mine; }
        if (sum == G) break;
        __builtin_amdgcn_s_sleep(1);
        if ((++sp & 255u) == 0u) { if (xb_ld(&bar[XB_TMO])) break; if (sp > XB_SPIN_CAP) { atomicAdd(&bar[XB_TMO], 1u); break; } }
    }
    nloc = mine > 0u ? mine : 1u; nx = cnt > 0u ? cnt : 1u;
}

__device__ __forceinline__ void xcd_barrier(const XcdBarrier& b) {
    asm volatile("s_waitcnt vmcnt(0)" ::: "memory");
    __syncthreads();
    if (threadIdx.x == 0) {
        unsigned* bar = b.bar;
        __builtin_amdgcn_s_waitcnt(0);
        unsigned nloc = b.st[0], nx = b.st[1];
        if (nloc == 0u) { xcd_barrier_complete(bar, b.x, nloc, nx); b.st[0] = nloc; b.st[1] = nx; }
        const unsigned old = xb_add(&bar[XB_XSUB(b.x)], 1u);
        const unsigned gen = old / nloc;
        if (old + 1u == (gen + 1u) * nloc) {
            __builtin_amdgcn_fence(__ATOMIC_RELEASE, "agent");
            asm volatile("s_waitcnt vmcnt(0)" ::: "memory");
            const unsigned og = xb_add(&bar[XB_TOP], 1u);
            const unsigned tg = og / nx;
            if (og + 1u == (tg + 1u) * nx) xb_add(&bar[XB_TOPGEN], 1u);
            else XB_SPIN(xb_ld(&bar[XB_TOPGEN]) == tg, bar);
            __builtin_amdgcn_fence(__ATOMIC_ACQUIRE, "agent");
            xb_add(&bar[XB_XGEN(b.x)], 1u);
            asm volatile("s_waitcnt vmcnt(0)" ::: "memory");
        } else {
            XB_SPIN(xb_ld(&bar[XB_XGEN(b.x)]) == gen, bar);
            __builtin_amdgcn_fence(__ATOMIC_ACQUIRE, "agent");
            asm volatile("s_waitcnt vmcnt(0)" ::: "memory");
        }
    }
    __syncthreads();
}


DI void grid_bar(unsigned* ctr, unsigned target) {
    asm volatile("s_waitcnt vmcnt(0)" ::: "memory");
    __syncthreads();
    if (threadIdx.x == 0) {
        __builtin_amdgcn_fence(__ATOMIC_RELEASE, "agent");
        asm volatile("s_waitcnt vmcnt(0)" ::: "memory");
        __hip_atomic_fetch_add(ctr, 1u, __ATOMIC_RELAXED, __HIP_MEMORY_SCOPE_AGENT);
        while (__hip_atomic_load(ctr, __ATOMIC_RELAXED, __HIP_MEMORY_SCOPE_AGENT) < target) __builtin_amdgcn_s_sleep(1);
        __builtin_amdgcn_fence(__ATOMIC_ACQUIRE, "agent");
        asm volatile("s_waitcnt vmcnt(0)" ::: "memory");
    }
    __syncthreads();
}

DI int perm_col(int kind, int n) {
    if (kind == 0) return n;
    if (kind == 1) { const int q = n >> 6, r = n & 63; return r < 32 ? q * 32 + r : DFF + q * 32 + (r - 32); }
    if (n < 2048) return n;
    if (n < 2560) return n + 16;
    if (n < 2576) return n - 512;
    return -1;
}
DI void convert_tile(const float* src, int K, int N, bf16_t* dst, int kind, int tile_n, int tile_k, float* t) {
    const int tid = otid(), tx = tid & 63, ty = tid >> 6;
    const int sc = perm_col(kind, tile_n * 64 + tx);
    {
        const int scc = sc >= 0 ? sc : 0;
        float lv[16];
#pragma unroll
        for (int i = 0; i < 16; ++i) lv[i] = src[(size_t)(tile_k * 64 + ty + 4 * i) * N + scc];
#pragma unroll
        for (int i = 0; i < 16; ++i) t[(ty + 4 * i) * 65 + tx] = sc >= 0 ? lv[i] : 0.f;
    }
    __syncthreads();
    const int rn = tid >> 2, kq = (tid & 3) * 16;
    unsigned w[8];
#pragma unroll
    for (int j = 0; j < 8; ++j) w[j] = pk_bf16(t[(kq + 2 * j) * 65 + rn], t[(kq + 2 * j + 1) * 65 + rn]);
    u32x4* dp = (u32x4*)(dst + (size_t)(tile_n * 64 + rn) * K + tile_k * 64 + kq);
    dp[0] = (u32x4){w[0], w[1], w[2], w[3]};
    dp[1] = (u32x4){w[4], w[5], w[6], w[7]};
    __syncthreads();
}
DI void mod_item(const Params& p, int item, char* smem) {
    float* sc = (float*)smem; float* red = sc + 9 * 1024;
    const int l = item / 144, cgp = item % 144, tid = otid();
    {
        float cv[36];
#pragma unroll
        for (int i = 0; i < 36; ++i) { const int idx = tid + THREADS * i, rr = idx >> 10, k = idx & 1023; cv[i] = rr < 8 ? p.c[rr * 1024 + k] : p.c_ctx[k]; }
#pragma unroll
        for (int i = 0; i < 36; ++i) sc[tid + THREADS * i] = cv[i] * __builtin_amdgcn_rcpf(1.f + __expf(-cv[i]));
    }
    __syncthreads();
    const int cx = tid & 63, kg = tid >> 6, col = cgp * 64 + cx;
    const float* w = p.w_ada + (size_t)l * 1024 * 9216 + col;
    float acc[9];
#pragma unroll
    for (int rr = 0; rr < 9; ++rr) acc[rr] = 0.f;
#pragma unroll 8
    for (int k = kg * 256; k < kg * 256 + 256; ++k) {
        const float wv = w[(size_t)k * 9216];
#pragma unroll
        for (int rr = 0; rr < 9; ++rr) acc[rr] += sc[rr * 1024 + k] * wv;
    }
#pragma unroll
    for (int rr = 0; rr < 9; ++rr) red[(kg * 9 + rr) * 64 + cx] = acc[rr];
    __syncthreads();
    for (int i = tid; i < 9 * 64; i += THREADS) {
        const int rr = i >> 6, c2 = i & 63, col2 = cgp * 64 + c2;
        const float s = red[(0 * 9 + rr) * 64 + c2] + red[(1 * 9 + rr) * 64 + c2] + red[(2 * 9 + rr) * 64 + c2] + red[(3 * 9 + rr) * 64 + c2];
        p.MOD[((size_t)l * 9 + rr) * 9216 + col2] = s + p.b_ada[l * 9216 + col2];
    }
    __syncthreads();
}
DI void sincos_d(double a, float& c, float& s) {
    const double TWO_PI = 6.283185307179586476925287;
    const double k = rint(a / TWO_PI);
    const double r = a - k * TWO_PI, r2 = r * r;
    double ts = 1.0, tc = 1.0;
#pragma unroll
    for (int n = 12; n >= 1; --n) { ts = 1.0 - ts * r2 / (double)((2 * n) * (2 * n + 1)); tc = 1.0 - tc * r2 / (double)((2 * n - 1) * (2 * n)); }
    s = (float)(r * ts); c = (float)tc;
}
DI void rope_item(const Params& p, int item) {
    const int idx = item * THREADS + otid();
    const int t = idx / 48, e = idx % 48;
    int pos, j; double base; float* dst;
    if (e < 16) { pos = e < 8 ? (t >> 6) : (t & 63); j = e & 7; base = 0.31622776601683794; dst = p.ROPEA + ((size_t)t * 16 + e) * 2; }
    else { const int e2 = e - 16; pos = e2 < 16 ? (t >> 6) : (t & 63); j = e2 & 15; base = 0.5623413251903491; dst = p.ROPED + ((size_t)t * 32 + e2) * 2; }
    double inv = 1.0;
    for (int q = 0; q < j; ++q) inv *= base;
    float c, s; sincos_d((double)pos * inv, c, s);
    dst[0] = c; dst[1] = s;
}
DI void phase_prologue(const Params& p, char* smem) {
    const int bid = obid(), G = ogrid();
    const int tid0 = otid();
    if (bid == 0 && tid0 < 2) {
        const int l = tid0; const float* dl = p.diff_lambda + l * 128;
        float s1 = 0.f, s2 = 0.f;
        for (int i = 0; i < 32; ++i) { s1 += dl[i] * dl[32 + i]; s2 += dl[64 + i] * dl[96 + i]; }
        const float lam_init = l == 0 ? 0.2f : 0.35550906759096926f;
        p.LAM[l] = __expf(s1) - __expf(s2) + lam_init;
    }
    for (int k = 0; k < (288 + G - 1) / G; ++k) { int it = bid + k * G; if (it >= 288) it = 287; mod_item(p, it, smem); }
    for (int it = bid; it < 1536; it += G) rope_item(p, it);
    for (int k = 0; k < (2 * 5184 + G - 1) / G; ++k) {
        int it = bid + k * G; if (it >= 2 * 5184) it = 2 * 5184 - 1;
        const int l = it / 5184; int r = it % 5184;
        const float* src; bf16_t* dst = p.WB + (size_t)l * W_LAYER; int K, N, kind, ntn;
        if (r < 1408) { src = p.ffn1_wi + (size_t)l * 1024 * 5632; dst += W_WI1; K = 1024; N = 5632; kind = 1; ntn = 88; }
        else if ((r -= 1408) < 704) { src = p.ffn1_wo + (size_t)l * 2816 * 1024; dst += W_WO1; K = 2816; N = 1024; kind = 0; ntn = 16; }
        else if ((r -= 704) < 1408) { src = p.ffn2_wi + (size_t)l * 1024 * 5632; dst += W_WI2; K = 1024; N = 5632; kind = 1; ntn = 88; }
        else if ((r -= 1408) < 704) { src = p.ffn2_wo + (size_t)l * 2816 * 1024; dst += W_WO2; K = 2816; N = 1024; kind = 0; ntn = 16; }
        else if ((r -= 704) < 704) { src = p.w_in + (size_t)l * 1024 * 2576; dst += W_WIN; K = 1024; N = 2576; kind = 2; ntn = 44; }
        else { r -= 704; src = p.w_out + (size_t)l * 1024 * 1024; dst += W_WOUT; K = 1024; N = 1024; kind = 0; ntn = 16; }
        convert_tile(src, K, N, dst, kind, r % ntn, r / ntn, (float*)smem);
    }
}

DI void ln_phase(const Params& p, int mode, const float* g, const float* bb, const float* modl, int s_next, int nrows) {
    const int tid_ = otid(); const int lane = tid_ & 63, wave = tid_ >> 6;
    const int bid_ = obid(), G_ = ogrid();
    const int stride = G_ * 4;
    float4 g4[4], b4[4];
#pragma unroll
    for (int i = 0; i < 4; ++i) { g4[i] = make_float4(1.f, 1.f, 1.f, 1.f); b4[i] = make_float4(0.f, 0.f, 0.f, 0.f); }
    if (mode != 0) {
#pragma unroll
        for (int i = 0; i < 4; ++i) { g4[i] = ((const float4*)g)[lane + 64 * i]; b4[i] = ((const float4*)bb)[lane + 64 * i]; }
    }
    int row = bid_ * 4 + wave;
    float4 nxt[4];
    if (row < nrows) {
        const float* src = mode == 0 ? (row < NL ? p.x + (size_t)row * DM : p.ctx + (size_t)(row - NL) * DM) : xrow_ptr(p, row);
#pragma unroll
        for (int i = 0; i < 4; ++i) nxt[i] = ((const float4*)src)[lane + 64 * i];
    }
    for (; row < nrows; row += stride) {
        float* dst = xrow_ptr(p, row);
        float v[16];
#pragma unroll
        for (int i = 0; i < 4; ++i) { v[4 * i] = nxt[i].x; v[4 * i + 1] = nxt[i].y; v[4 * i + 2] = nxt[i].z; v[4 * i + 3] = nxt[i].w; }
        const int rown = row + stride;
        if (rown < nrows) {
            const float* srcn = mode == 0 ? (rown < NL ? p.x + (size_t)rown * DM : p.ctx + (size_t)(rown - NL) * DM) : xrow_ptr(p, rown);
#pragma unroll
            for (int i = 0; i < 4; ++i) nxt[i] = ((const float4*)srcn)[lane + 64 * i];
        }
        float4 sh4[4], sc4[4];
        if (mode != 2) {
            const float* mrow = modl + (size_t)(row < NL ? (row >> 13) : 8) * 9216;
            const float4* sh = (const float4*)(mrow + (3 * s_next) * 1024);
            const float4* sc = (const float4*)(mrow + (3 * s_next + 1) * 1024);
#pragma unroll
            for (int i = 0; i < 4; ++i) { sh4[i] = sh[lane + 64 * i]; sc4[i] = sc[lane + 64 * i]; }
        }
        __builtin_amdgcn_sched_barrier(0);
        if (mode != 0) {
            float s = 0.f;
#pragma unroll
            for (int i = 0; i < 16; ++i) s += v[i];
            const float mu = wave_sum(s, lane) * (1.f / DM);
            float q = 0.f;
#pragma unroll
            for (int i = 0; i < 16; ++i) { v[i] -= mu; q += v[i] * v[i]; }
            const float rs = rsqrtf(wave_sum(q, lane) * (1.f / DM) + EPSV);
            if (mode == 1 && lane == 0) *(f32x2*)(p.STATS + (size_t)row * 2) = (f32x2){mu, rs};
#pragma unroll
            for (int i = 0; i < 4; ++i) {
                v[4 * i] = v[4 * i] * rs * g4[i].x + b4[i].x; v[4 * i + 1] = v[4 * i + 1] * rs * g4[i].y + b4[i].y;
                v[4 * i + 2] = v[4 * i + 2] * rs * g4[i].z + b4[i].z; v[4 * i + 3] = v[4 * i + 3] * rs * g4[i].w + b4[i].w;
            }
        }
        if (mode == 2) {
#pragma unroll
            for (int i = 0; i < 4; ++i) ((float4*)dst)[lane + 64 * i] = make_float4(v[4 * i], v[4 * i + 1], v[4 * i + 2], v[4 * i + 3]);
        }
        if (mode != 2) {
            float s = 0.f;
#pragma unroll
            for (int i = 0; i < 16; ++i) s += v[i];
            const float mu = wave_sum(s, lane) * (1.f / DM);
            float q = 0.f;
#pragma unroll
            for (int i = 0; i < 16; ++i) { v[i] -= mu; q += v[i] * v[i]; }
            const float rs = rsqrtf(wave_sum(q, lane) * (1.f / DM) + EPSV);
            bf16_t* hrow = p.H + (size_t)row * DM;
#pragma unroll
            for (int i = 0; i < 4; ++i) {
                const float4 a = sh4[i], c4 = sc4[i];
                u32x2 w;
                w.x = pk_bf16(v[4 * i] * rs * (1.f + c4.x) + a.x, v[4 * i + 1] * rs * (1.f + c4.y) + a.y);
                w.y = pk_bf16(v[4 * i + 2] * rs * (1.f + c4.z) + a.z, v[4 * i + 3] * rs * (1.f + c4.w) + a.w);
                ((u32x2*)hrow)[lane + 64 * i] = w;
            }
        }
    }
}

struct EpiSwiglu {
    static constexpr bool TAIL = false;
    DI void tail(const f32x16&, int, int, int, int, const float*) const {}
    DI void prefetch(int, int, float*) const {}
    bf16_t* ACT;
    DI void operator()(const f32x16 (&acc)[2][2], int row0, int col0, int r, int h, const float*) const {
        const int hc = (col0 >> 1) + r;
#pragma unroll
        for (int mi = 0; mi < 2; ++mi)
#pragma unroll
            for (int i = 0; i < 16; ++i) {
                const int row = row0 + mi * 32 + crow(i, h);
                const float gt = acc[mi][0][i], up = acc[mi][1][i];
                ACT[(size_t)row * DFF + hc] = to_bf16(gt * __builtin_amdgcn_rcpf(1.f + __expf(-gt)) * up);
            }
    }
};
struct EpiResid {
    static constexpr bool TAIL = true;
    const Params* p; const float* modl; int midx; float gs; int from_input; const float* pg; const float* pb;
    DI void prefetch(int row_tile0, int tid, float* sst) const {
        if (!from_input && tid < 256) *(f32x2*)(sst + 2 * tid) = *(const f32x2*)(p->STATS + (size_t)(row_tile0 + tid) * 2);
    }
    DI void operator()(const f32x16 (&acc)[2][2], int row0, int col0, int r, int h, const float* sst) const {
        const float* mrow = modl + (size_t)(row0 < NL ? (row0 >> 13) : 8) * 9216 + midx * 1024;
        const float gm0 = gs * mrow[col0 + r], gm1 = gs * mrow[col0 + 32 + r];
        const size_t off = (size_t)(4 * h) * DM + col0 + r;
        float* base = xrow_ptr(*p, row0) + off;
        const float* rbase = from_input ? (row0 < NL ? p->x + (size_t)row0 * DM : p->ctx + (size_t)(row0 - NL) * DM) + off : base;
        float g0 = 1.f, g1 = 1.f, b0 = 0.f, b1 = 0.f;
        if (!from_input) { g0 = pg[col0 + r]; g1 = pg[col0 + 32 + r]; b0 = pb[col0 + r]; b1 = pb[col0 + 32 + r]; }
        float x0[2][16], x1[2][16];
#pragma unroll
        for (int mi = 0; mi < 2; ++mi)
#pragma unroll
            for (int i = 0; i < 16; ++i) {
                const float* xr = rbase + (size_t)(mi * 32 + (i & 3) + 8 * (i >> 2)) * DM;
                x0[mi][i] = xr[0]; x1[mi][i] = xr[32];
            }
#pragma unroll
        for (int mi = 0; mi < 2; ++mi)
#pragma unroll
            for (int i = 0; i < 16; ++i) {
                float* xp = base + (size_t)(mi * 32 + (i & 3) + 8 * (i >> 2)) * DM;
                float a0 = x0[mi][i], a1 = x1[mi][i];
                if (!from_input) {
                    const f32x2 st = *(const f32x2*)(sst + 2 * (mi * 32 + (i & 3) + 8 * (i >> 2) + 4 * h));
                    a0 = (a0 - st.x) * st.y * g0 + b0; a1 = (a1 - st.x) * st.y * g1 + b1;
                }
                xp[0] = ALPHA * a0 + gm0 * acc[mi][0][i];
                xp[32] = ALPHA * a1 + gm1 * acc[mi][1][i];
            }
    }
    DI void tail(const f32x16& acc, int row0, int col0, int r, int h, const float* sst) const {
        const float* mrow = modl + (size_t)(row0 < NL ? (row0 >> 13) : 8) * 9216 + midx * 1024;
        const float gm0 = gs * mrow[col0 + r];
        const size_t off = (size_t)(4 * h) * DM + col0 + r;
        float* base = xrow_ptr(*p, row0) + off;
        const float* rbase = from_input ? (row0 < NL ? p->x + (size_t)row0 * DM : p->ctx + (size_t)(row0 - NL) * DM) + off : base;
        float g0 = 1.f, b0 = 0.f;
        if (!from_input) { g0 = pg[col0 + r]; b0 = pb[col0 + r]; }
        float x0[16];
#pragma unroll
        for (int i = 0; i < 16; ++i) x0[i] = rbase[(size_t)((i & 3) + 8 * (i >> 2)) * DM];
#pragma unroll
        for (int i = 0; i < 16; ++i) {
            float a0 = x0[i];
            if (!from_input) { const f32x2 st = *(const f32x2*)(sst + 2 * ((i & 3) + 8 * (i >> 2) + 4 * h)); a0 = (a0 - st.x) * st.y * g0 + b0; }
            base[(size_t)((i & 3) + 8 * (i >> 2)) * DM] = ALPHA * a0 + gm0 * acc[i];
        }
    }
};
struct EpiProj {
    static constexpr bool TAIL = false;
    DI void tail(const f32x16&, int, int, int, int, const float*) const {}
    DI void prefetch(int, int, float*) const {}
    bf16_t* PROJ; float* GATES; const float* gate_b;
    DI void operator()(const f32x16 (&acc)[2][2], int row0, int col0, int r, int h, const float*) const {
#pragma unroll
        for (int ni = 0; ni < 2; ++ni) {
            const int cb = col0 + ni * 32, col = cb + r;
            if (cb < PW) {
#pragma unroll
                for (int mi = 0; mi < 2; ++mi)
#pragma unroll
                    for (int i = 0; i < 16; ++i) PROJ[(size_t)(row0 + mi * 32 + crow(i, h)) * PW + col] = to_bf16(acc[mi][ni][i]);
            } else if (cb == PW && r < 16) {
                const float gb = gate_b[r];
#pragma unroll
                for (int mi = 0; mi < 2; ++mi)
#pragma unroll
                    for (int i = 0; i < 16; ++i) GATES[(size_t)(row0 + mi * 32 + crow(i, h)) * 16 + r] = acc[mi][ni][i] + gb;
            }
        }
    }
};

template <class Epi>
DI void gemm_phase(const bf16_t* A, const bf16_t* Bt, int K, int mtiles, int ntiles, const Epi& epi, char* smem) {
    bf16_t* sA = (bf16_t*)smem;
    bf16_t* sB = sA + 2 * 256 * 72;
    const int tid = otid512(), lane = tid & 63, wave = tid >> 6, wr = wave >> 2, wc = wave & 3, r = lane & 31, h = lane >> 5;
    const int bid_ = rbid(), G_ = rgrid();
    const int xcd = bid_ & 7, local = bid_ >> 3, nloc = G_ >> 3;
    const int mper = mtiles >> 3, mrem = mtiles & 7;
    const int mbeg = xcd * mper + (xcd < mrem ? xcd : mrem), mcnt = mper + (xcd < mrem ? 1 : 0);
    const int total = mcnt * ntiles, pg = 4 * ntiles, nk = K >> 6;
    const int srow = tid >> 3, skc = (tid & 7) * 8;
    const int main_total = Epi::TAIL ? (total / nloc) * nloc : total;
    int tcount = 0;
    for (int it = local; it < main_total; it += nloc) {
        const int grp = it / pg, rem = it - grp * pg;
        const int gl = mcnt - grp * 4, gsz = gl < 4 ? gl : 4;
        const int mt = mbeg + grp * 4 + rem % gsz, nt = rem / gsz;
        const bf16_t* Ag = A + (size_t)(mt * 256 + srow) * K + skc;
        const bf16_t* Bg = Bt + (size_t)(nt * 256 + srow) * K + skc;
        float* sst = (float*)(smem + 2 * HALF_LDS) + (tcount & 1) * 512; ++tcount;
        epi.prefetch(mt * 256, tid, sst);
        u32x4 ra[4], rb[4];
#pragma unroll
        for (int i = 0; i < 4; ++i) { ra[i] = *(const u32x4*)(Ag + (size_t)(64 * i) * K); rb[i] = *(const u32x4*)(Bg + (size_t)(64 * i) * K); }
#pragma unroll
        for (int i = 0; i < 4; ++i) { *(u32x4*)(sA + (srow + 64 * i) * 72 + skc) = ra[i]; *(u32x4*)(sB + (srow + 64 * i) * 72 + skc) = rb[i]; }
#pragma unroll
        for (int i = 0; i < 4; ++i) { ra[i] = *(const u32x4*)(Ag + (size_t)(64 * i) * K + 64); rb[i] = *(const u32x4*)(Bg + (size_t)(64 * i) * K + 64); }
        __syncthreads();
        f32x16 acc[4][2];
#pragma unroll
        for (int a = 0; a < 4; ++a)
#pragma unroll
            for (int b = 0; b < 2; ++b)
#pragma unroll
                for (int i = 0; i < 16; ++i) acc[a][b][i] = 0.f;
        for (int kt = 0; kt < nk; ++kt) {
            const int cur = kt & 1;
            const bf16_t* a_ = sA + cur * 256 * 72 + (wr * 128 + r) * 72 + 8 * h;
            const bf16_t* b_ = sB + cur * 256 * 72 + (wc * 64 + r) * 72 + 8 * h;
            bf16_t* wa = sA + (cur ^ 1) * 256 * 72 + srow * 72 + skc; bf16_t* wb = sB + (cur ^ 1) * 256 * 72 + srow * 72 + skc;
#define GEMM_KS(ks) { const bf16x8 b0 = *(const bf16x8*)(b_ + (ks) * 16), b1 = *(const bf16x8*)(b_ + 32 * 72 + (ks) * 16); \
                bf16x8 af[4]; _Pragma("unroll") for (int mi = 0; mi < 4; ++mi) af[mi] = *(const bf16x8*)(a_ + mi * 32 * 72 + (ks) * 16); \
                __builtin_amdgcn_s_setprio(1); \
                _Pragma("unroll") for (int mi = 0; mi < 4; ++mi) { acc[mi][0] = MFMA32(af[mi], b0, acc[mi][0]); acc[mi][1] = MFMA32(af[mi], b1, acc[mi][1]); } \
                __builtin_amdgcn_s_setprio(0); }
            GEMM_KS(0) GEMM_KS(1)
            __builtin_amdgcn_sched_barrier(0);
            if (kt + 1 < nk) {
#pragma unroll
                for (int i = 0; i < 4; ++i) *(u32x4*)(wa + 64 * i * 72) = ra[i];
            }
            if (kt + 2 < nk) {
#pragma unroll
                for (int i = 0; i < 4; ++i) ra[i] = *(const u32x4*)(Ag + (size_t)(64 * i) * K + (kt + 2) * 64);
            }
            GEMM_KS(2)
            __builtin_amdgcn_sched_barrier(0);
            if (kt + 1 < nk) {
#pragma unroll
                for (int i = 0; i < 4; ++i) *(u32x4*)(wb + 64 * i * 72) = rb[i];
            }
            if (kt + 2 < nk) {
#pragma unroll
                for (int i = 0; i < 4; ++i) rb[i] = *(const u32x4*)(Bg + (size_t)(64 * i) * K + (kt + 2) * 64);
            }
            GEMM_KS(3)
#undef GEMM_KS
            __syncthreads();
        }
        epi(reinterpret_cast<const f32x16(&)[2][2]>(acc[0]), mt * 256 + wr * 128, nt * 256 + wc * 64, r, h, sst + 2 * (wr * 128));
        epi(reinterpret_cast<const f32x16(&)[2][2]>(acc[2]), mt * 256 + wr * 128 + 64, nt * 256 + wc * 64, r, h, sst + 2 * (wr * 128 + 64));
    }
    if (Epi::TAIL) {
        const int nunits = (total - main_total) * 8;
        bf16_t* tB = sB;
        const int brow = tid >> 3;
        for (int u = local; u < nunits; u += nloc) {
            const int it = main_total + (u >> 3), cs = u & 7;
            const int grp = it / pg, rem = it - grp * pg;
            const int gl = mcnt - grp * 4, gsz = gl < 4 ? gl : 4;
            const int mt = mbeg + grp * 4 + rem % gsz, nt = rem / gsz;
            const bf16_t* Ag = A + (size_t)(mt * 256 + srow) * K + skc;
            const bf16_t* Bg = Bt + (size_t)(nt * 256 + cs * 32 + (brow & 31)) * K + skc;
            float* sst = (float*)(smem + 2 * HALF_LDS) + (tcount & 1) * 512; ++tcount;
            epi.prefetch(mt * 256, tid, sst);
            u32x4 ra[4][4], rb[4];
            __syncthreads();
#pragma unroll
            for (int i = 0; i < 4; ++i) ra[0][i] = *(const u32x4*)(Ag + (size_t)(64 * i) * K);
            rb[0] = *(const u32x4*)(Bg);
#pragma unroll
            for (int i = 0; i < 4; ++i) *(u32x4*)(sA + (srow + 64 * i) * 72 + skc) = ra[0][i];
            if (tid < 256) *(u32x4*)(tB + brow * 72 + skc) = rb[0];
#pragma unroll
            for (int t = 1; t <= 4; ++t) {
#pragma unroll
                for (int i = 0; i < 4; ++i) ra[t & 3][i] = *(const u32x4*)(Ag + (size_t)(64 * i) * K + t * 64);
                rb[t & 3] = *(const u32x4*)(Bg + t * 64);
            }
            __syncthreads();
            f32x16 acc1;
#pragma unroll
            for (int i = 0; i < 16; ++i) acc1[i] = 0.f;
            for (int kq = 0; kq < nk; kq += 4) {
#pragma unroll
                for (int j = 0; j < 4; ++j) {
                    const int kt = kq + j, cur = kt & 1, slot = (j + 1) & 3;
                    if (kt + 1 < nk) {
#pragma unroll
                        for (int i = 0; i < 4; ++i) *(u32x4*)(sA + (cur ^ 1) * 256 * 72 + (srow + 64 * i) * 72 + skc) = ra[slot][i];
                        if (tid < 256) *(u32x4*)(tB + (cur ^ 1) * 32 * 72 + brow * 72 + skc) = rb[slot];
                    }
                    if (kt + 5 < nk) {
#pragma unroll
                        for (int i = 0; i < 4; ++i) ra[slot][i] = *(const u32x4*)(Ag + (size_t)(64 * i) * K + (kt + 5) * 64);
                        rb[slot] = *(const u32x4*)(Bg + (kt + 5) * 64);
                    }
                    const bf16_t* a_ = sA + cur * 256 * 72 + (wave * 32 + r) * 72 + 8 * h;
                    const bf16_t* b_ = tB + cur * 32 * 72 + r * 72 + 8 * h;
#pragma unroll
                    for (int ks = 0; ks < 4; ++ks) acc1 = MFMA32(*(const bf16x8*)(a_ + ks * 16), *(const bf16x8*)(b_ + ks * 16), acc1);
                    __syncthreads();
                }
            }
            epi.tail(acc1, mt * 256 + wave * 32, nt * 256 + cs * 32, r, h, sst + 2 * (wave * 32));
        }
    }
}

DI size_t seq_row(int b, int ctile64) {
    return ctile64 < 4 ? (size_t)NL + b * CTXL + ctile64 * 64 : (size_t)b * SEQL + (ctile64 - 4) * 64;
}
DI void prepkv_item(const Params& p, int layer, int item, char* smem) {
    const int hsel = item % 6, kt = (item / 6) % NCH, b = item / (6 * NCH);
    const int tid = otid(), key = tid >> 2, sub = tid & 3;
    const size_t row0 = seq_row(b, kt);
    const bf16_t* prow = p.ACT + (row0 + key) * PW;
    const bool lat = kt >= 4;
    const int t = (kt - 4) * 64 + key;
    int vcol;
    if (hsel < 4) {
        const int m = sub >> 1, g = sub & 1;
        const int cb = 256 + hsel * 64 + m * 32 + 8 * g;
        float lo[8], hi[8];
        unpack8(*(const u32x4*)(prow + cb), lo); unpack8(*(const u32x4*)(prow + cb + 16), hi);
        if (lat) {
            const float* tab = p.ROPEA + ((size_t)t * 16 + 8 * g) * 2;
#pragma unroll
            for (int j = 0; j < 8; ++j) { const float c = tab[2 * j], s = tab[2 * j + 1]; const float a = lo[j], bq = hi[j]; lo[j] = a * c - bq * s; hi[j] = bq * c + a * s; }
        }
        bf16_t* kd = p.KA + ((size_t)(b * 4 + hsel) * NKEY + kt * 64 + key) * 64 + m * 32 + 8 * g;
        *(u32x4*)kd = pack8(lo); *(u32x4*)(kd + 16) = pack8(hi);
        vcol = 512 + hsel * 64;
    } else {
        const int kv = hsel - 4, g = sub;
        const int cb = 2304 + kv * 64 + 8 * g;
        float lo[8], hi[8];
        unpack8(*(const u32x4*)(prow + cb), lo); unpack8(*(const u32x4*)(prow + cb + 32), hi);
        float ss = 0.f;
#pragma unroll
        for (int j = 0; j < 8; ++j) ss += lo[j] * lo[j] + hi[j] * hi[j];
        ss += shx(ss, tid & 63, 1); ss += shx(ss, tid & 63, 2);
        const float rs = rsqrtf(ss * (1.f / 64.f) + EPSV);
        const float* kg = p.kng + layer * 64;
#pragma unroll
        for (int j = 0; j < 8; ++j) { lo[j] *= rs * kg[8 * g + j]; hi[j] *= rs * kg[32 + 8 * g + j]; }
        if (lat) {
            const float* tab = p.ROPED + ((size_t)t * 32 + 8 * g) * 2;
#pragma unroll
            for (int j = 0; j < 8; ++j) { const float c = tab[2 * j], s = tab[2 * j + 1]; const float a = lo[j], bq = hi[j]; lo[j] = a * c - bq * s; hi[j] = bq * c + a * s; }
        }
        bf16_t* kd = p.KD + ((size_t)(b * 2 + kv) * NKEY + kt * 64 + key) * 64 + 8 * g;
        *(u32x4*)kd = pack8(lo); *(u32x4*)(kd + 32) = pack8(hi);
        vcol = 2432 + kv * 64;
    }
    bf16_t* sT = (bf16_t*)smem;
    {
        const int k2 = tid >> 2, c0 = (tid & 3) * 16;
        const u32x4 w0 = *(const u32x4*)(p.ACT + (row0 + k2) * PW + vcol + c0), w1 = *(const u32x4*)(p.ACT + (row0 + k2) * PW + vcol + c0 + 8);
        unsigned* d = (unsigned*)(sT + k2 * 66 + c0);
        d[0] = w0.x; d[1] = w0.y; d[2] = w0.z; d[3] = w0.w; d[4] = w1.x; d[5] = w1.y; d[6] = w1.z; d[7] = w1.w;
    }
    __syncthreads();
    {
        const int dv = tid >> 2, kq = (tid & 3) * 16;
        unsigned w[8];
#pragma unroll
        for (int j = 0; j < 8; ++j) w[j] = (unsigned)sT[(kq + 2 * j) * 66 + dv] | ((unsigned)sT[(kq + 2 * j + 1) * 66 + dv] << 16);
        bf16_t* vd = (hsel < 4 ? p.VTA + ((size_t)(b * 4 + hsel) * 64 + dv) * NKEY : p.VTD + ((size_t)(b * 2 + hsel - 4) * 64 + dv) * NKEY) + kt * 64 + kq;
        *(u32x4*)vd = (u32x4){w[0], w[1], w[2], w[3]};
        *(u32x4*)(vd + 8) = (u32x4){w[4], w[5], w[6], w[7]};
    }
    __syncthreads();
}

DI void pool_item(const Params& p, int layer, int seq, int tile, int g, char* smem, bool load_w) {
    float* su = (float*)smem;
    float* sd = su + 80 * 64;
    float* sw = sd + 64 * 68;
    const int tid = otid();
    const bool isctx = seq >= 8; const int b = seq & 7;
    const int Ls = isctx ? CTXL : SEQL;
    const size_t rbase = isctx ? (size_t)NL + b * CTXL : (size_t)b * SEQL;
    const int t0 = tile * 64, w2 = 1 << g;
    {
        u32x4 uch[3]; float wv[16];
        const float* pw = p.pool_w + ((size_t)layer * 4 + g) * 4096;
#pragma unroll
        for (int i = 0; i < 3; ++i) {
            const int c = tid + THREADS * i, rr = c >> 3, c8 = (c & 7) * 8, t = t0 - 8 + rr;
            uch[i] = (u32x4){0u, 0u, 0u, 0u};
            if (c < 640 && t >= 0 && t < Ls) uch[i] = *(const u32x4*)(p.ACT + (rbase + t) * PW + 768 + g * 64 + c8);
        }
        if (load_w) {
#pragma unroll
            for (int i = 0; i < 16; ++i) wv[i] = pw[tid + THREADS * i];
        }
#pragma unroll
        for (int i = 0; i < 3; ++i) {
            const int c = tid + THREADS * i, rr = c >> 3, c8 = (c & 7) * 8;
            if (c < 640) { float f[8]; unpack8(uch[i], f);
#pragma unroll
                for (int j = 0; j < 8; ++j) su[rr * 64 + c8 + j] = f[j]; }
        }
        if (load_w) {
#pragma unroll
            for (int i = 0; i < 16; ++i) sw[tid + THREADS * i] = wv[i];
        }
    }
    __syncthreads();
    const int e = tid & 63, tq = tid >> 6;
#pragma unroll 4
    for (int i = 0; i < 16; ++i) {
        const int tt = tq * 16 + i, t = t0 + tt;
        const int lo = t - w2 < 0 ? 0 : t - w2, hi = t + w2 > Ls ? Ls : t + w2;
        float s = 0.f;
        for (int q = lo; q < hi; ++q) s += su[(q - t0 + 8) * 64 + e];
        sd[tt * 68 + e] = s * __builtin_amdgcn_rcpf((float)(hi - lo)) - su[(tt + 8) * 64 + e];
    }
    __syncthreads();
    float acc[16];
#pragma unroll
    for (int i = 0; i < 16; ++i) acc[i] = 0.f;
#pragma unroll 1
    for (int c4 = 0; c4 < 16; ++c4) {
        const float w0 = sw[(4 * c4) * 64 + e], w1 = sw[(4 * c4 + 1) * 64 + e], w2_ = sw[(4 * c4 + 2) * 64 + e], w3 = sw[(4 * c4 + 3) * 64 + e];
#pragma unroll
        for (int i = 0; i < 16; ++i) { const float4 d = *(const float4*)(sd + (tq * 16 + i) * 68 + 4 * c4); acc[i] += d.x * w0 + d.y * w1 + d.z * w2_ + d.w * w3; }
    }
    const float ps = p.pool_scale[layer * 256 + g * 64 + e];
#pragma unroll
    for (int i = 0; i < 16; ++i) p.H[(rbase + t0 + tq * 16 + i) * DM + 256 + g * 64 + e] = to_bf16(acc[i] * ps);
    __syncthreads();
}

DI float log_sigmoid(float x) { return fminf(x, 0.f) - __logf(1.f + __expf(-fabsf(x))); }
DI void ml_gates(const Params& p, size_t row0, int head, float* sg) {
    const int tidg = otid();
    if (tidg < 64) {
        const int lane = tidg;
        const float* gp = p.GATES + (row0 + lane) * 16 + head;
        const float lif = gp[0], lff = log_sigmoid(gp[4]), lib = gp[8], lfb = log_sigmoid(gp[12]);
        float vf = lff, vb = lfb;
#pragma unroll
        for (int o = 1; o < 64; o <<= 1) {
            const float tf = shl(vf, lane - o), tb = shl(vb, lane + o);
            if (lane >= o) vf += tf;
            if (lane + o < 64) vb += tb;
        }
        sg[lane] = vf; sg[64 + lane] = lif; sg[128 + lane] = vb; sg[192 + lane] = lib;
    }
}
DI int chain_pos(int dir, int c) { return dir == 0 ? c : (c < 4 ? 3 - c : 4 + (131 - c)); }

DI void ml1_item(const Params& p, int item, char* smem) {
    float* sk = (float*)smem;
    float* sv = sk + 4096;
    float* sg = sv + 4096;
    float* swt = sg + 256;
    const int c = item % NCH, head = (item / NCH) & 3, b = item / (NCH * 4);
    const int tid = otid();
    const size_t row0 = seq_row(b, c);
    {
        u32x4 kk[2], vv[2];
#pragma unroll
        for (int i = 0; i < 2; ++i) {
            const int q = tid + THREADS * i, rr = q >> 3, c8 = (q & 7) * 8;
            kk[i] = *(const u32x4*)(p.ACT + (row0 + rr) * PW + 1280 + head * 64 + c8);
            vv[i] = *(const u32x4*)(p.ACT + (row0 + rr) * PW + 1536 + head * 64 + c8);
        }
#pragma unroll
        for (int i = 0; i < 2; ++i) {
            const int q = tid + THREADS * i, rr = q >> 3, c8 = (q & 7) * 8; float f[8];
            unpack8(kk[i], f);
#pragma unroll
            for (int j = 0; j < 8; ++j) sk[rr * 64 + c8 + j] = f[j];
            unpack8(vv[i], f);
#pragma unroll
            for (int j = 0; j < 8; ++j) sv[rr * 64 + c8 + j] = f[j];
        }
    }
    ml_gates(p, row0, head, sg);
    __syncthreads();
    if (tid < 64) { swt[tid] = __expf(sg[63] - sg[tid] + sg[64 + tid]); swt[64 + tid] = __expf(sg[128] - sg[128 + tid] + sg[192 + tid]); }
    __syncthreads();
    const int e = tid & 63, vq = tid >> 6;
    float af[16], ab[16], nf = 0.f, nb = 0.f;
#pragma unroll
    for (int i = 0; i < 16; ++i) { af[i] = 0.f; ab[i] = 0.f; }
#pragma unroll 2
    for (int t = 0; t < 64; ++t) {
        const float kk = sk[t * 64 + e], kf = kk * swt[t], kb = kk * swt[64 + t];
        nf += kf; nb += kb;
#pragma unroll
        for (int i4 = 0; i4 < 4; ++i4) {
            const float4 vv = *(const float4*)(sv + t * 64 + vq * 16 + 4 * i4);
            af[4 * i4] += vv.x * kf; af[4 * i4 + 1] += vv.y * kf; af[4 * i4 + 2] += vv.z * kf; af[4 * i4 + 3] += vv.w * kf;
            ab[4 * i4] += vv.x * kb; ab[4 * i4 + 1] += vv.y * kb; ab[4 * i4 + 2] += vv.z * kb; ab[4 * i4 + 3] += vv.w * kb;
        }
    }
    const size_t chf = ((size_t)(b * 4 + head) * 2 + 0) * NCH + chain_pos(0, c), chb = ((size_t)(b * 4 + head) * 2 + 1) * NCH + chain_pos(1, c);
    bf16_t* df = p.ST + chf * STSZ; bf16_t* db = p.ST + chb * STSZ;
#pragma unroll
    for (int i = 0; i < 16; ++i) { df[(vq * 16 + i) * 64 + e] = to_bf16(af[i]); db[(vq * 16 + i) * 64 + e] = to_bf16(ab[i]); }
    if (vq == 0) { df[4096 + e] = to_bf16(nf); db[4096 + e] = to_bf16(nb); }
    if (tid == 0) { p.DEC[chf] = __expf(sg[63]); p.DEC[chb] = __expf(sg[128]); }
    __syncthreads();
}
DI void scan_item(const Params& p, int item) {
    const int chain = item / 9, wd = (item % 9) * THREADS + otid();
    if (wd >= STSZ / 2) return;
    unsigned* st = (unsigned*)(p.ST + (size_t)chain * NCH * STSZ) + wd;
    const float* dec = p.DEC + chain * NCH;
    float S0 = 0.f, S1 = 0.f;
    for (int q0 = 0; q0 < NCH; q0 += 22) {
        unsigned tmp[22]; float dd[22];
#pragma unroll
        for (int i = 0; i < 22; ++i) { tmp[i] = st[(size_t)(q0 + i) * (STSZ / 2)]; dd[i] = dec[q0 + i]; }
#pragma unroll
        for (int i = 0; i < 22; ++i) { st[(size_t)(q0 + i) * (STSZ / 2)] = pk_bf16(S0, S1); S0 = dd[i] * S0 + bflo(tmp[i]); S1 = dd[i] * S1 + bfhi(tmp[i]); }
    }
}
DI void ml3_pair(const Params& p, int layer, int it2, int cpc, int n5, int last, char* smem) {
    const int tid = otid(), lane = tid & 63, wave = tid >> 6, pr = wave >> 1, jw = wave & 1, r = lane & 31, h = lane >> 5, t2 = tid & 127;
    int idx = 2 * it2 + pr; if (idx >= n5) idx = n5 - 1;
    const int item = (idx / cpc) * NCH + (last ? 4 : 0) + idx % cpc;
    const int c = item % NCH, head = (item / NCH) & 3, b = item / (NCH * 4);
    const size_t row0 = seq_row(b, c);
    char* slot = smem + pr * 36864;
    bf16_t* sKb = (bf16_t*)slot;
    bf16_t* sVt = sKb + 64 * 72;
    bf16_t* sC = sVt + 64 * 68;
    float* sg = (float*)(sC + 64 * 72);
    float* sn = sg + 256;
    {
        u32x4 kq[4], vq[4];
#pragma unroll
        for (int i = 0; i < 4; ++i) {
            const int cc = t2 + 128 * i, row = cc >> 3, c8 = (cc & 7) * 8;
            const bf16_t* src = p.ACT + (row0 + row) * PW + head * 64 + c8;
            kq[i] = *(const u32x4*)(src + 1280); vq[i] = *(const u32x4*)(src + 1536);
        }
        __builtin_amdgcn_sched_barrier(0);
#pragma unroll
        for (int i = 0; i < 4; ++i) {
            const int cc = t2 + 128 * i, row = cc >> 3, c8 = (cc & 7) * 8;
            *(u32x4*)(sKb + row * 72 + c8) = kq[i];
            const u32x4 vv = vq[i];
            sVt[(c8 + 0) * 68 + row] = (bf16_t)(vv.x & 0xffffu); sVt[(c8 + 1) * 68 + row] = (bf16_t)(vv.x >> 16);
            sVt[(c8 + 2) * 68 + row] = (bf16_t)(vv.y & 0xffffu); sVt[(c8 + 3) * 68 + row] = (bf16_t)(vv.y >> 16);
            sVt[(c8 + 4) * 68 + row] = (bf16_t)(vv.z & 0xffffu); sVt[(c8 + 5) * 68 + row] = (bf16_t)(vv.z >> 16);
            sVt[(c8 + 6) * 68 + row] = (bf16_t)(vv.w & 0xffffu); sVt[(c8 + 7) * 68 + row] = (bf16_t)(vv.w >> 16);
        }
    }
    const size_t chf = ((size_t)(b * 4 + head) * 2 + 0) * NCH + chain_pos(0, c), chb = ((size_t)(b * 4 + head) * 2 + 1) * NCH + chain_pos(1, c);
    if (jw == 0) {
        const float* gp = p.GATES + (row0 + lane) * 16 + head;
        const float lif = gp[0], lff = log_sigmoid(gp[4]), lib = gp[8], lfb = log_sigmoid(gp[12]);
        float vf = lff, vb = lfb;
#pragma unroll
        for (int o = 1; o < 64; o <<= 1) {
            const float tf = shl(vf, lane - o), tb = shl(vb, lane + o);
            if (lane >= o) vf += tf;
            if (lane + o < 64) vb += tb;
        }
        sg[lane] = vf; sg[64 + lane] = lif - vf; sg[128 + lane] = vb; sg[192 + lane] = lib - vb;
    } else {
        sn[lane] = bf2f(p.ST[chf * STSZ + 4096 + lane]); sn[64 + lane] = bf2f(p.ST[chb * STSZ + 4096 + lane]);
    }
    const int j = 32 * jw + r;
    const bf16_t* qp = p.ACT + (row0 + j) * PW + 1024 + head * 64 + 8 * h;
    bf16x8 qf[4];
#pragma unroll
    for (int ks = 0; ks < 4; ++ks) qf[ks] = __builtin_bit_cast(bf16x8, *(const u32x4*)(qp + 16 * ks));
    f32x16 hs[2];
#pragma unroll
    for (int d = 0; d < 2; ++d)
#pragma unroll
        for (int i = 0; i < 16; ++i) hs[d][i] = 0.f;
#pragma unroll 1
    for (int dir = 0; dir < 2; ++dir) {
        __syncthreads();
        {
            const bf16_t* st = p.ST + (dir == 0 ? chf : chb) * STSZ;
            u32x4 cf[4];
#pragma unroll
            for (int i = 0; i < 4; ++i) { const int cc = t2 + 128 * i, v = cc >> 3, e8 = (cc & 7) * 8; cf[i] = *(const u32x4*)(st + v * 64 + e8); }
#pragma unroll
            for (int i = 0; i < 4; ++i) { const int cc = t2 + 128 * i, v = cc >> 3, e8 = (cc & 7) * 8; *(u32x4*)(sC + v * 72 + e8) = cf[i]; }
        }
        __syncthreads();
        const float* bc = sg + dir * 128; const float* bl = bc + 64; const float* nn = sn + dir * 64;
        float nq = 0.f;
#pragma unroll
        for (int ks = 0; ks < 4; ++ks) {
            float qv[8]; unpack8(__builtin_bit_cast(u32x4, qf[ks]), qv);
#pragma unroll
            for (int jj = 0; jj < 8; ++jj) nq += qv[jj] * nn[16 * ks + 8 * h + jj];
        }
        nq += shx(nq, lane, 32);
        f32x16 x[2];
#pragma unroll
        for (int kb = 0; kb < 2; ++kb)
#pragma unroll
            for (int i = 0; i < 16; ++i) x[kb][i] = 0.f;
#pragma unroll
        for (int ks = 0; ks < 4; ++ks) {
            const bf16x8 a0 = *(const bf16x8*)(sKb + r * 72 + 16 * ks + 8 * h), a1 = *(const bf16x8*)(sKb + (32 + r) * 72 + 16 * ks + 8 * h);
            x[0] = MFMA32(a0, qf[ks], x[0]); x[1] = MFMA32(a1, qf[ks], x[1]);
        }
        const float bcj = bc[j];
        float den = 0.f;
#pragma unroll
        for (int kb = 0; kb < 2; ++kb)
#pragma unroll
            for (int i = 0; i < 16; ++i) {
                const int k = 32 * kb + crow(i, h);
                const bool ok = dir == 0 ? (k <= j) : (k >= j);
                const float w = ok ? 0.125f * x[kb][i] * __expf(bcj + bl[k]) : 0.f;
                x[kb][i] = w; den += w;
            }
        den += shx(den, lane, 32);
        f32x16 num[2], ci[2];
#pragma unroll
        for (int d = 0; d < 2; ++d)
#pragma unroll
            for (int i = 0; i < 16; ++i) { num[d][i] = 0.f; ci[d][i] = 0.f; }
#pragma unroll
        for (int kb = 0; kb < 2; ++kb)
#pragma unroll
            for (int st = 0; st < 2; ++st) {
                u32x4 w;
                w.x = pk_bf16(x[kb][8 * st], x[kb][8 * st + 1]); w.y = pk_bf16(x[kb][8 * st + 2], x[kb][8 * st + 3]);
                w.z = pk_bf16(x[kb][8 * st + 4], x[kb][8 * st + 5]); w.w = pk_bf16(x[kb][8 * st + 6], x[kb][8 * st + 7]);
                const bf16x8 pfr = __builtin_bit_cast(bf16x8, w);
#pragma unroll
                for (int d = 0; d < 2; ++d) {
                    const bf16_t* vp = sVt + (32 * d + r) * 68 + 32 * kb + 16 * st + 4 * h;
                    const s16x4 lo = *(const s16x4*)vp, hi = *(const s16x4*)(vp + 8);
                    const bf16x8 vf = __builtin_shufflevector(lo, hi, 0, 1, 2, 3, 4, 5, 6, 7);
                    num[d] = MFMA32(vf, pfr, num[d]);
                }
            }
#pragma unroll
        for (int ks = 0; ks < 4; ++ks)
#pragma unroll
            for (int d = 0; d < 2; ++d) {
                const bf16x8 cf = *(const bf16x8*)(sC + (32 * d + r) * 72 + 16 * ks + 8 * h);
                ci[d] = MFMA32(cf, qf[ks], ci[d]);
            }
        const float wi = 0.125f * __expf(bcj);
        const float inv = 1.f / fmaxf(fabsf(den + wi * nq), 1.f);
#pragma unroll
        for (int d = 0; d < 2; ++d)
#pragma unroll
            for (int i = 0; i < 16; ++i) hs[d][i] += (num[d][i] + wi * ci[d][i]) * inv;
    }
    float ss = 0.f;
#pragma unroll
    for (int d = 0; d < 2; ++d)
#pragma unroll
        for (int i = 0; i < 16; ++i) ss += hs[d][i] * hs[d][i];
    ss += shx(ss, lane, 32);
    const float rs = rsqrtf(ss * (1.f / 64.f) + EPSV);
    const float* gm = p.ml_norm_g + layer * 256 + head * 64;
    const bf16_t* op = p.ACT + (row0 + j) * PW + 1792 + head * 64;
    bf16_t* outp = p.H + (row0 + j) * DM + 512 + head * 64;
    u32x2 owv[2][4]; float gmv[2][16];
#pragma unroll
    for (int d = 0; d < 2; ++d)
#pragma unroll
        for (int ig = 0; ig < 4; ++ig) {
            const int v0 = 32 * d + 8 * ig + 4 * h;
            owv[d][ig] = *(const u32x2*)(op + v0);
#pragma unroll
            for (int jj = 0; jj < 4; ++jj) gmv[d][4 * ig + jj] = gm[v0 + jj];
        }
#pragma unroll
    for (int d = 0; d < 2; ++d)
#pragma unroll
        for (int ig = 0; ig < 4; ++ig) {
            const int v0 = 32 * d + 8 * ig + 4 * h;
            const u32x2 ow = owv[d][ig];
            const float o0 = bflo(ow.x), o1 = bfhi(ow.x), o2 = bflo(ow.y), o3 = bfhi(ow.y);
            u32x2 w;
            w.x = pk_bf16(hs[d][4 * ig] * rs * gmv[d][4 * ig] * __builtin_amdgcn_rcpf(1.f + __expf(-o0)), hs[d][4 * ig + 1] * rs * gmv[d][4 * ig + 1] * __builtin_amdgcn_rcpf(1.f + __expf(-o1)));
            w.y = pk_bf16(hs[d][4 * ig + 2] * rs * gmv[d][4 * ig + 2] * __builtin_amdgcn_rcpf(1.f + __expf(-o2)), hs[d][4 * ig + 3] * rs * gmv[d][4 * ig + 3] * __builtin_amdgcn_rcpf(1.f + __expf(-o3)));
            *(u32x2*)(outp + v0) = w;
        }
    __syncthreads();
}

template <int DK>
DI void attn_item(const Params& p, int layer, int b, int hd, int qt, int ctxq, char* smem) {
    constexpr int NH = DK == 32 ? 4 : 2, NKS = DK / 16;
    bf16_t* sK = (bf16_t*)smem;
    bf16_t* sV = sK + 2 * 64 * 72;
    const int tid = otid(), lane = tid & 63, wave = tid >> 6, r = lane & 31, h = lane >> 5;
    const bf16_t* Kg = (DK == 32 ? p.KA : p.KD) + (size_t)(b * NH + hd) * NKEY * 64;
    const bf16_t* Vg = (DK == 32 ? p.VTA : p.VTD) + (size_t)(b * NH + hd) * 64 * NKEY;
    const int nkt = ctxq ? 4 : NCH;
    const int ql = qt * 128 + wave * 32 + r;
    const size_t prow = ctxq ? (size_t)NL + b * CTXL + ql : (size_t)b * SEQL + ql;
    const bf16_t* qp = p.ACT + prow * PW;
    bf16x8 qf[2][NKS];
    if (DK == 32) {
        const float qs = 0.17677669529663687f * 1.4426950408889634f;
#pragma unroll
        for (int s = 0; s < 2; ++s) {
            float lo[8], hi[8];
            unpack8(*(const u32x4*)(qp + hd * 64 + 32 * s + 8 * h), lo); unpack8(*(const u32x4*)(qp + hd * 64 + 32 * s + 16 + 8 * h), hi);
            if (!ctxq) {
                const float* tab = p.ROPEA + ((size_t)ql * 16 + 8 * h) * 2;
#pragma unroll
                for (int j = 0; j < 8; ++j) { const float c = tab[2 * j], sn = tab[2 * j + 1]; const float a = lo[j], bq = hi[j]; lo[j] = a * c - bq * sn; hi[j] = bq * c + a * sn; }
            }
#pragma unroll
            for (int j = 0; j < 8; ++j) { lo[j] *= qs; hi[j] *= qs; }
            qf[s][0] = __builtin_bit_cast(bf16x8, pack8(lo)); qf[s][1 % NKS] = __builtin_bit_cast(bf16x8, pack8(hi));
        }
    } else {
        const float qs = 0.125f * 1.4426950408889634f;
        const float* qg = p.qng + layer * 64;
#pragma unroll
        for (int s = 0; s < 2; ++s) {
            float xv[4][8];
            float ss = 0.f;
#pragma unroll
            for (int ks = 0; ks < 4; ++ks) { unpack8(*(const u32x4*)(qp + 2048 + hd * 128 + s * 64 + 16 * ks + 8 * h), xv[ks]);
#pragma unroll
                for (int j = 0; j < 8; ++j) ss += xv[ks][j] * xv[ks][j]; }
            ss += shx(ss, lane, 32);
            const float rs = rsqrtf(ss * (1.f / 64.f) + EPSV);
#pragma unroll
            for (int ks = 0; ks < 4; ++ks)
#pragma unroll
                for (int j = 0; j < 8; ++j) xv[ks][j] *= rs * qg[16 * ks + 8 * h + j];
            if (!ctxq) {
#pragma unroll
                for (int ks = 0; ks < 2; ++ks) {
                    const float* tab = p.ROPED + ((size_t)ql * 32 + 16 * ks + 8 * h) * 2;
#pragma unroll
                    for (int j = 0; j < 8; ++j) { const float c = tab[2 * j], sn = tab[2 * j + 1]; const float a = xv[ks][j], bq = xv[ks + 2][j]; xv[ks][j] = a * c - bq * sn; xv[ks + 2][j] = bq * c + a * sn; }
                }
            }
#pragma unroll
            for (int ks = 0; ks < 4; ++ks) {
#pragma unroll
                for (int j = 0; j < 8; ++j) xv[ks][j] *= qs;
                qf[s][ks % NKS] = __builtin_bit_cast(bf16x8, pack8(xv[ks]));
            }
        }
    }
    bf16_t* sQ = sV + 2 * 64 * 68 + wave * (2 * NKS * 64 * 8);
#pragma unroll
    for (int s = 0; s < 2; ++s)
#pragma unroll
        for (int ks = 0; ks < NKS; ++ks) *(bf16x8*)(sQ + ((s * NKS + ks) * 64 + lane) * 8) = qf[s][ks];
    float m_[2] = {-1e30f, -1e30f}, l_[2] = {0.f, 0.f};
    f32x16 O[2][2];
#pragma unroll
    for (int s = 0; s < 2; ++s)
#pragma unroll
        for (int d = 0; d < 2; ++d)
#pragma unroll
            for (int i = 0; i < 16; ++i) O[s][d][i] = 0.f;
    const int srow = tid >> 3, sc8 = (tid & 7) * 8;
    u32x4 rk[2], rv[2];
#pragma unroll
    for (int i = 0; i < 2; ++i) { rk[i] = *(const u32x4*)(Kg + (size_t)(srow + 32 * i) * 64 + sc8); rv[i] = *(const u32x4*)(Vg + (size_t)(srow + 32 * i) * NKEY + sc8); }
#pragma unroll
    for (int i = 0; i < 2; ++i) {
        *(u32x4*)(sK + (srow + 32 * i) * 72 + sc8) = rk[i];
        *(u32x2*)(sV + (srow + 32 * i) * 68 + sc8) = (u32x2){rv[i].x, rv[i].y}; *(u32x2*)(sV + (srow + 32 * i) * 68 + sc8 + 4) = (u32x2){rv[i].z, rv[i].w};
    }
    __syncthreads();
    for (int kt = 0; kt < nkt; ++kt) {
        const int cur = kt & 1;
        const bf16_t* kb_ = sK + cur * 64 * 72; const bf16_t* vb_ = sV + cur * 64 * 68;
#pragma unroll
        for (int s = 0; s < 2; ++s) {
            if (s == 1) {
                if (kt + 1 < nkt) {
#pragma unroll
                    for (int i = 0; i < 2; ++i) { rk[i] = *(const u32x4*)(Kg + (size_t)((kt + 1) * 64 + srow + 32 * i) * 64 + sc8); rv[i] = *(const u32x4*)(Vg + (size_t)(srow + 32 * i) * NKEY + (kt + 1) * 64 + sc8); }
                }
            }
            f32x16 x[2];
#pragma unroll
            for (int kb = 0; kb < 2; ++kb)
#pragma unroll
                for (int i = 0; i < 16; ++i) x[kb][i] = 0.f;
            const int kofs = DK == 32 ? 32 * s : 0;
#pragma unroll
            for (int ks = 0; ks < NKS; ++ks) {
                const bf16x8 a0 = *(const bf16x8*)(kb_ + r * 72 + kofs + 16 * ks + 8 * h), a1 = *(const bf16x8*)(kb_ + (32 + r) * 72 + kofs + 16 * ks + 8 * h);
                const bf16x8 qv = *(const bf16x8*)(sQ + ((s * NKS + ks) * 64 + lane) * 8);
                x[0] = MFMA32(a0, qv, x[0]); x[1] = MFMA32(a1, qv, x[1]);
            }
            float mx = x[0][0];
#pragma unroll
            for (int i = 1; i < 16; ++i) mx = fmaxf(mx, x[0][i]);
#pragma unroll
            for (int i = 0; i < 16; ++i) mx = fmaxf(mx, x[1][i]);
            mx = fmaxf(mx, shx(mx, lane, 32));
            if (__builtin_amdgcn_ballot_w64(mx > m_[s] + 8.f) != 0) {
                const float mn = fmaxf(m_[s], mx);
                const float al = __builtin_amdgcn_exp2f(m_[s] - mn);
                m_[s] = mn;
                l_[s] *= al;
#pragma unroll
                for (int d = 0; d < 2; ++d)
#pragma unroll
                    for (int i = 0; i < 16; ++i) O[s][d][i] *= al;
            }
            const f32x2 mref = {m_[s], m_[s]};
            float ps = 0.f;
#pragma unroll
            for (int kb = 0; kb < 2; ++kb)
#pragma unroll
                for (int i2 = 0; i2 < 8; ++i2) {
                    f32x2 t = {x[kb][2 * i2], x[kb][2 * i2 + 1]};
                    asm("v_pk_add_f32 %0, %1, %2 neg_lo:[0,1] neg_hi:[0,1]" : "=v"(t) : "v"(t), "v"(mref));
                    const float e0 = __builtin_amdgcn_exp2f(t.x), e1 = __builtin_amdgcn_exp2f(t.y);
                    x[kb][2 * i2] = e0; x[kb][2 * i2 + 1] = e1; ps += e0 + e1;
                }
            l_[s] += ps;
#pragma unroll
            for (int kb = 0; kb < 2; ++kb)
#pragma unroll
                for (int st = 0; st < 2; ++st) {
                    u32x4 w;
                    w.x = pk_bf16(x[kb][8 * st], x[kb][8 * st + 1]); w.y = pk_bf16(x[kb][8 * st + 2], x[kb][8 * st + 3]);
                    w.z = pk_bf16(x[kb][8 * st + 4], x[kb][8 * st + 5]); w.w = pk_bf16(x[kb][8 * st + 6], x[kb][8 * st + 7]);
                    const bf16x8 pfr = __builtin_bit_cast(bf16x8, w);
#pragma unroll
                    for (int d = 0; d < 2; ++d) {
                        const bf16_t* vp = vb_ + (32 * d + r) * 68 + 32 * kb + 16 * st + 4 * h;
                        const s16x4 lo = *(const s16x4*)vp, hi = *(const s16x4*)(vp + 8);
                        const bf16x8 vf = __builtin_shufflevector(lo, hi, 0, 1, 2, 3, 4, 5, 6, 7);
                        O[s][d] = MFMA32(vf, pfr, O[s][d]);
                    }
                }
        }
        if (kt + 1 < nkt) {
            bf16_t* wk = sK + (cur ^ 1) * 64 * 72; bf16_t* wv = sV + (cur ^ 1) * 64 * 68;
#pragma unroll
            for (int i = 0; i < 2; ++i) {
                *(u32x4*)(wk + (srow + 32 * i) * 72 + sc8) = rk[i];
                *(u32x2*)(wv + (srow + 32 * i) * 68 + sc8) = (u32x2){rv[i].x, rv[i].y}; *(u32x2*)(wv + (srow + 32 * i) * 68 + sc8 + 4) = (u32x2){rv[i].z, rv[i].w};
            }
        }
        __syncthreads();
    }
    const float inv0 = 1.f / (l_[0] + shx(l_[0], lane, 32)), inv1 = 1.f / (l_[1] + shx(l_[1], lane, 32));
    bf16_t* orow = p.H + prow * DM;
    if (DK == 32) {
        const float lam = p.LAM[layer];
        const float lam_init = layer == 0 ? 0.2f : 0.35550906759096926f;
        float ss = 0.f;
#pragma unroll
        for (int d = 0; d < 2; ++d)
#pragma unroll
            for (int i = 0; i < 16; ++i) { const float o = O[0][d][i] * inv0 - lam * O[1][d][i] * inv1; O[0][d][i] = o; ss += o * o; }
        ss += shx(ss, lane, 32);
        const float rs = rsqrtf(ss * (1.f / 64.f) + EPSV) * (1.f - lam_init);
        const float* gn = p.diff_norm_g + layer * 256 + hd * 64;
        float gnv[2][16];
#pragma unroll
        for (int d = 0; d < 2; ++d)
#pragma unroll
            for (int i = 0; i < 16; ++i) gnv[d][i] = gn[32 * d + crow(i, h)];
#pragma unroll
        for (int d = 0; d < 2; ++d)
#pragma unroll
            for (int ig = 0; ig < 4; ++ig) {
                const int dv = 32 * d + 8 * ig + 4 * h;
                u32x2 w;
                w.x = pk_bf16(O[0][d][4 * ig] * rs * gnv[d][4 * ig], O[0][d][4 * ig + 1] * rs * gnv[d][4 * ig + 1]);
                w.y = pk_bf16(O[0][d][4 * ig + 2] * rs * gnv[d][4 * ig + 2], O[0][d][4 * ig + 3] * rs * gnv[d][4 * ig + 3]);
                *(u32x2*)(orow + hd * 64 + dv) = w;
            }
    } else {
#pragma unroll
        for (int s = 0; s < 2; ++s) {
            const float inv = s == 0 ? inv0 : inv1;
#pragma unroll
            for (int d = 0; d < 2; ++d)
#pragma unroll
                for (int ig = 0; ig < 4; ++ig) {
                    const int dv = 32 * d + 8 * ig + 4 * h;
                    u32x2 w;
                    w.x = pk_bf16(O[s][d][4 * ig] * inv, O[s][d][4 * ig + 1] * inv);
                    w.y = pk_bf16(O[s][d][4 * ig + 2] * inv, O[s][d][4 * ig + 3] * inv);
                    *(u32x2*)(orow + 768 + hd * 128 + s * 64 + dv) = w;
                }
        }
    }
}

constexpr int NPHASE = 2 + 12 * 2;
typedef const Params __attribute__((address_space(4)))* KParams;
DI void run_phase(int ph, char* smem) {
    KParams kp = (KParams)__builtin_amdgcn_kernarg_segment_ptr();
    asm volatile("" : "+s"(kp));
#if defined(__HIP_DEVICE_COMPILE__)
    const Params p = *kp;
#else
    const Params p{};
#endif
    const int bid = obid(), G = ogrid();
    char* smh = smem + ohalf() * HALF_LDS;
    if (ph == 0) { phase_prologue(p, smh); return; }
    if (ph == 1) { ln_phase(p, 0, nullptr, nullptr, p.MOD, 0, NT); return; }
    const int l = (ph - 2) / 12, q = (ph - 2) % 12;
    const bool last = l == 1;
    const float* modl = p.MOD + (size_t)l * 9 * 9216;
    const bf16_t* wb = p.WB + (size_t)l * W_LAYER;
    const int mt_post = last ? NL / 256 : NT / 256;
    if (q == 0 || q == 9) {
        EpiSwiglu e{p.ACT};
        gemm_phase(p.H, wb + (q == 0 ? W_WI1 : W_WI2), 1024, q == 0 ? NT / 256 : mt_post, 22, e, smem);
    } else if (q == 1 || q == 10 || q == 7) {
        const int pl = q == 1 ? l - 1 : l, pj = q == 7 ? 0 : (q == 10 ? 1 : 2);
        const int fin = (l == 0 && q == 1) ? 1 : 0;
        const float* pgp = fin ? p.ln_g : p.ln_g + ((size_t)pl * 3 + pj) * 1024; const float* pbp = fin ? p.ln_b : p.ln_b + ((size_t)pl * 3 + pj) * 1024;
        EpiResid e{&p, modl, q == 1 ? 2 : (q == 10 ? 8 : 5), q == 7 ? 1.0f : 0.5f, fin, pgp, pbp};
        const bf16_t* A = q == 7 ? p.H : p.ACT;
        const bf16_t* B = wb + (q == 1 ? W_WO1 : (q == 10 ? W_WO2 : W_WOUT));
        gemm_phase(A, B, q == 7 ? 1024 : DFF, q == 1 ? NT / 256 : mt_post, 4, e, smem);
    } else if (q == 2 || q == 8 || q == 11) {
        const int j = q == 2 ? 0 : (q == 8 ? 1 : 2);
        const float* g = p.ln_g + ((size_t)l * 3 + j) * 1024; const float* bb = p.ln_b + ((size_t)l * 3 + j) * 1024;
        if (q == 11 && last) ln_phase(p, 2, g, bb, modl, 0, NL);
        else if (q == 11) ln_phase(p, 1, g, bb, p.MOD + (size_t)(l + 1) * 9 * 9216, 0, NT);
        else ln_phase(p, 1, g, bb, modl, q == 2 ? 1 : 2, q == 2 ? NT : mt_post * 256);
    } else if (q == 3) {
        EpiProj e{p.ACT, p.GATES, p.ml_gate_b + l * 16};
        gemm_phase(p.H, wb + W_WIN, 1024, NT / 256, PWP / 256, e, smem);
    } else if (q == 4) {
        const int n1 = NB * NCH * 6, n2 = NB * 4 * NCH;
        for (int k = 0; k < (n1 + G - 1) / G; ++k) { int it = bid + k * G; if (it >= n1) it = n1 - 1; prepkv_item(p, l, it, smh); }
        for (int k = 0; k < (n2 + G - 1) / G; ++k) { int it = bid + k * G; if (it >= n2) it = n2 - 1; ml1_item(p, it, smh); }
        const int npl = NB * 128 * 4, npc = last ? 0 : NB * 4 * 4, n3 = npl + npc;
        int pool_g = -1;
        for (int k = 0; k < (n3 + G - 1) / G; ++k) {
            int it = bid + k * G; if (it >= n3) it = n3 - 1;
            const int gsel = it & 3;
            const bool lw = gsel != pool_g; pool_g = gsel;
            if (it < npl) pool_item(p, l, it >> 9, (it >> 2) & 127, gsel, smh, lw);
            else { const int i2 = it - npl; pool_item(p, l, 8 + (i2 >> 4), (i2 >> 2) & 3, gsel, smh, lw); }
        }
    } else if (q == 5) {
        for (int it = bid; it < 64 * 9; it += G) scan_item(p, it);
        const int rb_ = rbid(), xcd = rb_ & 7, local = (rb_ >> 3) * 2 + ohalf(), nloc = (rgrid() >> 3) * 2;
        for (int k = 0; k < (384 + nloc - 1) / nloc; ++k) {
            int idx = local + k * nloc; if (idx >= 384) idx = 383;
            const int pair = (idx >> 6) * 8 + xcd, qt = idx & 63, b = pair / 6, hh = pair % 6;
            if (hh < 4) attn_item<32>(p, l, b, hh, qt, 0, smh); else attn_item<64>(p, l, b, hh - 4, qt, 0, smh);
        }
        if (!last) {
            const int n4 = NB * 6 * 2;
            for (int k = 0; k < (n4 + G - 1) / G; ++k) {
                int it = bid + k * G; if (it >= n4) it = n4 - 1;
                const int qt = it & 1, pair = it >> 1, b = pair / 6, hh = pair % 6;
                if (hh < 4) attn_item<32>(p, l, b, hh, qt, 1, smh); else attn_item<64>(p, l, b, hh - 4, qt, 1, smh);
            }
        }
    } else if (q == 6) {
        const int cpc = last ? 128 : NCH, n5 = NB * 4 * cpc, n5p = (n5 + 1) >> 1;
        for (int k = 0; k < (n5p + G - 1) / G; ++k) {
            int it = bid + k * G; if (it >= n5p) it = n5p - 1;
            ml3_pair(p, l, it, cpc, n5, last ? 1 : 0, smh);
        }
    }
}

__global__ void __launch_bounds__(WG_THREADS, 2) fwd_megakernel(Params p, int ph_lo, int ph_hi) {
    extern __shared__ __attribute__((aligned(16))) char smem[];
    __shared__ uint4 xb_words;
    if (threadIdx.x == 0) xb_words = make_uint4(0u, 0u, 0u, 0u);
    __syncthreads();
    const XcdBarrier xb = xcd_barrier_post(p.XBAR, (volatile XB_LAS unsigned*)&xb_words);
    for (int ph = ph_lo; ph < ph_hi; ++ph) {
        run_phase(ph, smem);
        if (ph + 1 < ph_hi) {
            if (ph == ph_lo) cg::this_grid().sync();
            else xcd_barrier(xb);
        }
    }
}

static inline size_t align_up(size_t v) { return (v + 255) & ~(size_t)255; }

extern "C" void kernel_launch(void* const* d_in, const int* in_sizes, int n_in, void* d_out, int out_size, void* d_ws, size_t ws_size, hipStream_t stream) {
    (void)in_sizes; (void)n_in; (void)out_size;
    static int grid_blocks = 0;
    if (!grid_blocks) {
        int dev = 0, cus = 0, per_cu = 0;
        hipGetDevice(&dev);
        hipDeviceGetAttribute(&cus, hipDeviceAttributeMultiprocessorCount, dev);
        if (hipFuncSetAttribute((const void*)fwd_megakernel, hipFuncAttributeMaxDynamicSharedMemorySize, LDS_BYTES) != hipSuccess) fprintf(stderr, "hipFuncSetAttribute failed\n");
        hipOccupancyMaxActiveBlocksPerMultiprocessor(&per_cu, fwd_megakernel, WG_THREADS, LDS_BYTES);
        if (per_cu > 1) per_cu = 1;
        if (per_cu < 1) per_cu = 1;
        grid_blocks = cus * per_cu;
        grid_blocks -= grid_blocks % 8;
    }
    Params p;
    memset(&p, 0, sizeof(p));
    const float* const* in = (const float* const*)d_in;
    p.x = in[0]; p.c = in[1]; p.ctx = in[2]; p.c_ctx = in[3]; p.w_ada = in[4]; p.b_ada = in[5]; p.ln_g = in[6]; p.ln_b = in[7];
    p.ffn1_wi = in[8]; p.ffn1_wo = in[9]; p.ffn2_wi = in[10]; p.ffn2_wo = in[11]; p.w_in = in[12]; p.w_out = in[13];
    p.diff_lambda = in[14]; p.diff_norm_g = in[15]; p.pool_w = in[16]; p.pool_scale = in[17]; p.ml_gate_b = in[18]; p.ml_norm_g = in[19]; p.qng = in[20]; p.kng = in[21];
    p.XL = (float*)d_out;
    char* w = (char*)d_ws; size_t off = 0;
    auto take = [&](size_t bytes) { char* r = w + off; off = align_up(off + bytes); return r; };
    p.WB = (bf16_t*)take(2 * W_LAYER * 2);
    p.MOD = (float*)take((size_t)2 * 9 * 9216 * 4);
    p.ROPEA = (float*)take((size_t)SEQL * 16 * 2 * 4);
    p.ROPED = (float*)take((size_t)SEQL * 32 * 2 * 4);
    p.LAM = (float*)take(256);
    p.XC = (float*)take((size_t)NC * DM * 4);
    p.H = (bf16_t*)take((size_t)NT * DM * 2);
    p.ACT = (bf16_t*)take((size_t)NT * DFF * 2);
    p.GATES = (float*)take((size_t)NT * 16 * 4);
    p.KA = (bf16_t*)take((size_t)NB * 4 * NKEY * 64 * 2);
    p.VTA = (bf16_t*)take((size_t)NB * 4 * NKEY * 64 * 2);
    p.KD = (bf16_t*)take((size_t)NB * 2 * NKEY * 64 * 2);
    p.VTD = (bf16_t*)take((size_t)NB * 2 * NKEY * 64 * 2);
    p.ST = (bf16_t*)take((size_t)NB * 4 * 2 * NCH * STSZ * 2);
    p.DEC = (float*)take((size_t)NB * 4 * 2 * NCH * 4);
    p.SYNC = (unsigned*)take(4096);
    p.STATS = (float*)take((size_t)NT * 2 * 4);
    p.XBAR = (unsigned*)take((size_t)XCD_BAR_WORDS * 4);
    if (off > ws_size) { fprintf(stderr, "workspace too small: need %zu have %zu\n", off, ws_size); return; }
#if MK_SPLIT
    for (int ph = 0; ph < NPHASE; ++ph) hipLaunchKernelGGL(fwd_megakernel, dim3(grid_blocks), dim3(WG_THREADS), LDS_BYTES, stream, p, ph, ph + 1);
#else
    (void)hipMemsetAsync(p.XBAR, 0, (size_t)XCD_BAR_WORDS * 4, stream);
    int lo = 0, hi = NPHASE;
    void* args[] = {&p, &lo, &hi};
    hipError_t e = hipLaunchCooperativeKernel((const void*)fwd_megakernel, dim3(grid_blocks), dim3(WG_THREADS), args, LDS_BYTES, stream);
    if (e != hipSuccess) fprintf(stderr, "cooperative launch failed: %s (grid %d)\n", hipGetErrorString(e), grid_blocks);
#endif
}
```

```cpp
#include <hip/hip_runtime.h>
#include <hip/hip_cooperative_groups.h>
#include <cstdio>
#include <cstdint>
#include <cstring>
namespace cg = cooperative_groups;

#ifndef MK_SPLIT
#define MK_SPLIT 0
#endif

typedef unsigned short bf16_t;
typedef short bf16x8 __attribute__((ext_vector_type(8)));
typedef short s16x4 __attribute__((ext_vector_type(4)));
typedef float f32x16 __attribute__((ext_vector_type(16)));
typedef float f32x2 __attribute__((ext_vector_type(2)));
typedef __bf16 bf16v2 __attribute__((ext_vector_type(2)));
typedef unsigned u32x4 __attribute__((ext_vector_type(4)));
typedef unsigned u32x2 __attribute__((ext_vector_type(2)));

#define DI __device__ __forceinline__
#define MFMA32(a, b, c) __builtin_amdgcn_mfma_f32_32x32x16_bf16((a), (b), (c), 0, 0, 0)

constexpr int DM = 1024, NB = 8, SEQL = 8192, CTXL = 256, DFF = 2816;
constexpr int NL = NB * SEQL;
constexpr int NC = NB * CTXL;
constexpr int NT = NL + NC;
constexpr int NKEY = SEQL + CTXL;
constexpr int PW = 2560;
constexpr int PWP = 2816;
constexpr int NCH = 132;
constexpr int STSZ = 4160;
constexpr float EPSV = 1e-6f;
constexpr float ALPHA = 1.4142135623730951f;
constexpr int THREADS = 256;
constexpr int WG_THREADS = 512;
constexpr int HALF_LDS = 73728;
constexpr int LDS_BYTES = 2 * HALF_LDS + 4096;

struct Params {
    const float *x, *c, *ctx, *c_ctx, *w_ada, *b_ada, *ln_g, *ln_b, *ffn1_wi, *ffn1_wo, *ffn2_wi, *ffn2_wo, *w_in, *w_out,
        *diff_lambda, *diff_norm_g, *pool_w, *pool_scale, *ml_gate_b, *ml_norm_g, *qng, *kng;
    float* XL;
    float* XC;
    bf16_t* WB;
    float* MOD;
    float* ROPEA;
    float* ROPED;
    float* LAM;
    bf16_t* H;
    bf16_t* ACT;
    float* GATES;
    bf16_t *KA, *VTA, *KD, *VTD;
    bf16_t* ST;
    float* DEC;
    unsigned* SYNC;
    unsigned* XBAR;
    float* STATS;
};

constexpr size_t W_WI1 = 0, W_WO1 = W_WI1 + (size_t)5632 * 1024, W_WI2 = W_WO1 + (size_t)1024 * 2816, W_WO2 = W_WI2 + (size_t)5632 * 1024,
                 W_WIN = W_WO2 + (size_t)1024 * 2816, W_WOUT = W_WIN + (size_t)PWP * 1024, W_LAYER = W_WOUT + (size_t)1024 * 1024;

DI unsigned pk_bf16(float a, float b) { f32x2 v = {a, b}; bf16v2 r = __builtin_convertvector(v, bf16v2); return __builtin_bit_cast(unsigned, r); }
DI bf16_t to_bf16(float a) { return (bf16_t)(pk_bf16(a, 0.f) & 0xffffu); }
DI float bf2f(unsigned short x) { return __uint_as_float(((unsigned)x) << 16); }
DI float bflo(unsigned w) { return __uint_as_float(w << 16); }
DI float bfhi(unsigned w) { return __uint_as_float(w & 0xffff0000u); }
DI int otid() { int t = threadIdx.x & 255; asm volatile("" : "+v"(t)); return t; }
DI int otid512() { int t = threadIdx.x; asm volatile("" : "+v"(t)); return t; }
DI int ohalf() { int t = __builtin_amdgcn_readfirstlane(threadIdx.x >> 8); asm volatile("" : "+s"(t)); return t; }
DI int obid() { int t = blockIdx.x * 2 + __builtin_amdgcn_readfirstlane(threadIdx.x >> 8); asm volatile("" : "+s"(t)); return t; }
DI int ogrid() { int t = gridDim.x * 2; asm volatile("" : "+s"(t)); return t; }
DI int rbid() { int t = blockIdx.x; asm volatile("" : "+s"(t)); return t; }
DI int rgrid() { int t = gridDim.x; asm volatile("" : "+s"(t)); return t; }
DI int crow(int i, int h) { return (i & 3) + 8 * (i >> 2) + 4 * h; }
DI float shx(float v, int lane, int m) { return __int_as_float(__builtin_amdgcn_ds_bpermute((lane ^ m) << 2, __float_as_int(v))); }
DI float shl(float v, int src_lane) { return __int_as_float(__builtin_amdgcn_ds_bpermute(src_lane << 2, __float_as_int(v))); }
DI float wave_sum(float v, int lane) {
#pragma unroll
    for (int o = 32; o > 0; o >>= 1) v += shx(v, lane, o);
    return v;
}
DI void unpack8(u32x4 w, float* f) {
    f[0] = bflo(w.x); f[1] = bfhi(w.x); f[2] = bflo(w.y); f[3] = bfhi(w.y); f[4] = bflo(w.z); f[5] = bfhi(w.z); f[6] = bflo(w.w); f[7] = bfhi(w.w);
}
DI u32x4 pack8(const float* f) { u32x4 w; w.x = pk_bf16(f[0], f[1]); w.y = pk_bf16(f[2], f[3]); w.z = pk_bf16(f[4], f[5]); w.w = pk_bf16(f[6], f[7]); return w; }
DI float* xrow_ptr(const Params& p, int row) { return row < NL ? p.XL + (size_t)row * DM : p.XC + (size_t)(row - NL) * DM; }

#define XB_TMO      128
#define XB_XCNT(j)  (256  + 64 * (j))
#define XB_XSUB(j)  (1280 + 64 * (j))
#define XB_XGEN(j)  (2304 + 64 * (j))
#define XB_TOP      3328
#define XB_TOPGEN   3392
#define XCD_BAR_WORDS 3456
#define XB_SPIN_CAP (1u << 18)
#define XB_LAS __attribute__((address_space(3)))

__device__ __forceinline__ unsigned xb_ld(unsigned* p)              { return __hip_atomic_load(p, __ATOMIC_RELAXED, __HIP_MEMORY_SCOPE_AGENT); }
__device__ __forceinline__ unsigned xb_add(unsigned* p, unsigned v) { return __hip_atomic_fetch_add(p, v, __ATOMIC_RELAXED, __HIP_MEMORY_SCOPE_AGENT); }
__device__ __forceinline__ unsigned xb_xcc_id() { return (unsigned)__builtin_amdgcn_s_getreg((3 << 11) | 20) & 0xFu; }
#define XB_SPIN(cond, bar) do { unsigned _sp = 0; while (cond) { __builtin_amdgcn_s_sleep(1); \
    if ((++_sp & 255u) == 0u) { if (xb_ld(&(bar)[XB_TMO])) break; if (_sp > XB_SPIN_CAP) { atomicAdd(&(bar)[XB_TMO], 1u); break; } } } } while (0)

struct XcdBarrier {
    unsigned* bar; unsigned x;
    volatile XB_LAS unsigned* st;
};

__device__ __forceinline__ XcdBarrier xcd_barrier_post(unsigned* bar, volatile XB_LAS unsigned* st) {
    XcdBarrier b; b.bar = bar; b.x = xb_xcc_id(); b.st = st;
    if (threadIdx.x == 0) (void)xb_add(&bar[XB_XCNT(b.x)], 1u);
    return b;
}
__device__ __forceinline__ void xcd_barrier_complete(unsigned* bar, unsigned x, unsigned& nloc, unsigned& nx) {
    const unsigned G = gridDim.x * gridDim.y * gridDim.z;
    unsigned sum, cnt, mine, sp = 0u;
    for (;;) {
        sum = 0u; cnt = 0u; mine = 0u;
#pragma unroll
        for (unsigned j = 0; j < 16; ++j) { const unsigned c = xb_ld(&bar[XB_XCNT(j)]); sum += c; cnt += (c > 0u) ? 1u : 0u; mine = (j == x) ? c : mine; }
        if (sum == G) break;
        __builtin_amdgcn_s_sleep(1);
        if ((++sp & 255u) == 0u) { if (xb_ld(&bar[XB_TMO])) break; if (sp > XB_SPIN_CAP) { atomicAdd(&bar[XB_TMO], 1u); break; } }
    }
    nloc = mine > 0u ? mine : 1u; nx = cnt > 0u ? cnt : 1u;
}

__device__ __forceinline__ void xcd_barrier(const XcdBarrier& b) {
    asm volatile("s_waitcnt vmcnt(0)" ::: "memory");
    __syncthreads();
    if (threadIdx.x == 0) {
        unsigned* bar = b.bar;
        __builtin_amdgcn_s_waitcnt(0);
        unsigned nloc = b.st[0], nx = b.st[1];
        if (nloc == 0u) { xcd_barrier_complete(bar, b.x, nloc, nx); b.st[0] = nloc; b.st[1] = nx; }
        const unsigned old = xb_add(&bar[XB_XSUB(b.x)], 1u);
        const unsigned gen = old / nloc;
        if (old + 1u == (gen + 1u) * nloc) {
            __builtin_amdgcn_fence(__ATOMIC_RELEASE, "agent");
            asm volatile("s_waitcnt vmcnt(0)" ::: "memory");
            const unsigned og = xb_add(&bar[XB_TOP], 1u);
            const unsigned tg = og / nx;
            if (og + 1u == (tg + 1u) * nx) xb_add(&bar[XB_TOPGEN], 1u);
            else XB_SPIN(xb_ld(&bar[XB_TOPGEN]) == tg, bar);
            __builtin_amdgcn_fence(__ATOMIC_ACQUIRE, "agent");
            xb_add(&bar[XB_XGEN(b.x)], 1u);
            asm volatile("s_waitcnt vmcnt(0)" ::: "memory");
        } else {
            XB_SPIN(xb_ld(&bar[XB_XGEN(b.x)]) == gen, bar);
            __builtin_amdgcn_fence(__ATOMIC_ACQUIRE, "agent");
            asm volatile("s_waitcnt vmcnt(0)" ::: "memory");
        }
    }
    __syncthreads();
}


DI void grid_bar(unsigned* ctr, unsigned target) {
    asm volatile("s_waitcnt vmcnt(0)" ::: "memory");
    __syncthreads();
    if (threadIdx.x == 0) {
        __builtin_amdgcn_fence(__ATOMIC_RELEASE, "agent");
        asm volatile("s_waitcnt vmcnt(0)" ::: "memory");
        __hip_atomic_fetch_add(ctr, 1u, __ATOMIC_RELAXED, __HIP_MEMORY_SCOPE_AGENT);
        while (__hip_atomic_load(ctr, __ATOMIC_RELAXED, __HIP_MEMORY_SCOPE_AGENT) < target) __builtin_amdgcn_s_sleep(1);
        __builtin_amdgcn_fence(__ATOMIC_ACQUIRE, "agent");
        asm volatile("s_waitcnt vmcnt(0)" ::: "memory");
    }
    __syncthreads();
}

DI int perm_col(int kind, int n) {
    if (kind == 0) return n;
    if (kind == 1) { const int q = n >> 6, r = n & 63; return r < 32 ? q * 32 + r : DFF + q * 32 + (r - 32); }
    if (n < 2048) return n;
    if (n < 2560) return n + 16;
    if (n < 2576) return n - 512;
    return -1;
}
DI void convert_tile(const float* src, int K, int N, bf16_t* dst, int kind, int tile_n, int tile_k, float* t) {
    const int tid = otid(), tx = tid & 63, ty = tid >> 6;
    const int sc = perm_col(kind, tile_n * 64 + tx);
    {
        const int scc = sc >= 0 ? sc : 0;
        float lv[16];
#pragma unroll
        for (int i = 0; i < 16; ++i) lv[i] = src[(size_t)(tile_k * 64 + ty + 4 * i) * N + scc];
#pragma unroll
        for (int i = 0; i < 16; ++i) t[(ty + 4 * i) * 65 + tx] = sc >= 0 ? lv[i] : 0.f;
    }
    __syncthreads();
    const int rn = tid >> 2, kq = (tid & 3) * 16;
    unsigned w[8];
#pragma unroll
    for (int j = 0; j < 8; ++j) w[j] = pk_bf16(t[(kq + 2 * j) * 65 + rn], t[(kq + 2 * j + 1) * 65 + rn]);
    u32x4* dp = (u32x4*)(dst + (size_t)(tile_n * 64 + rn) * K + tile_k * 64 + kq);
    dp[0] = (u32x4){w[0], w[1], w[2], w[3]};
    dp[1] = (u32x4){w[4], w[5], w[6], w[7]};
    __syncthreads();
}
DI void mod_item(const Params& p, int item, char* smem) {
    float* sc = (float*)smem; float* red = sc + 9 * 1024;
    const int l = item / 144, cgp = item % 144, tid = otid();
    {
        float cv[36];
#pragma unroll
        for (int i = 0; i < 36; ++i) { const int idx = tid + THREADS * i, rr = idx >> 10, k = idx & 1023; cv[i] = rr < 8 ? p.c[rr * 1024 + k] : p.c_ctx[k]; }
#pragma unroll
        for (int i = 0; i < 36; ++i) sc[tid + THREADS * i] = cv[i] * __builtin_amdgcn_rcpf(1.f + __expf(-cv[i]));
    }
    __syncthreads();
    const int cx = tid & 63, kg = tid >> 6, col = cgp * 64 + cx;
    const float* w = p.w_ada + (size_t)l * 1024 * 9216 + col;
    float acc[9];
#pragma unroll
    for (int rr = 0; rr < 9; ++rr) acc[rr] = 0.f;
#pragma unroll 8
    for (int k = kg * 256; k < kg * 256 + 256; ++k) {
        const float wv = w[(size_t)k * 9216];
#pragma unroll
        for (int rr = 0; rr < 9; ++rr) acc[rr] += sc[rr * 1024 + k] * wv;
    }
#pragma unroll
    for (int rr = 0; rr < 9; ++rr) red[(kg * 9 + rr) * 64 + cx] = acc[rr];
    __syncthreads();
    for (int i = tid; i < 9 * 64; i += THREADS) {
        const int rr = i >> 6, c2 = i & 63, col2 = cgp * 64 + c2;
        const float s = red[(0 * 9 + rr) * 64 + c2] + red[(1 * 9 + rr) * 64 + c2] + red[(2 * 9 + rr) * 64 + c2] + red[(3 * 9 + rr) * 64 + c2];
        p.MOD[((size_t)l * 9 + rr) * 9216 + col2] = s + p.b_ada[l * 9216 + col2];
    }
    __syncthreads();
}
DI void sincos_d(double a, float& c, float& s) {
    const double TWO_PI = 6.283185307179586476925287;
    const double k = rint(a / TWO_PI);
    const double r = a - k * TWO_PI, r2 = r * r;
    double ts = 1.0, tc = 1.0;
#pragma unroll
    for (int n = 12; n >= 1; --n) { ts = 1.0 - ts * r2 / (double)((2 * n) * (2 * n + 1)); tc = 1.0 - tc * r2 / (double)((2 * n - 1) * (2 * n)); }
    s = (float)(r * ts); c = (float)tc;
}
DI void rope_item(const Params& p, int item) {
    const int idx = item * THREADS + otid();
    const int t = idx / 48, e = idx % 48;
    int pos, j; double base; float* dst;
    if (e < 16) { pos = e < 8 ? (t >> 6) : (t & 63); j = e & 7; base = 0.31622776601683794; dst = p.ROPEA + ((size_t)t * 16 + e) * 2; }
    else { const int e2 = e - 16; pos = e2 < 16 ? (t >> 6) : (t & 63); j = e2 & 15; base = 0.5623413251903491; dst = p.ROPED + ((size_t)t * 32 + e2) * 2; }
    double inv = 1.0;
    for (int q = 0; q < j; ++q) inv *= base;
    float c, s; sincos_d((double)pos * inv, c, s);
    dst[0] = c; dst[1] = s;
}
DI void phase_prologue(const Params& p, char* smem) {
    const int bid = obid(), G = ogrid();
    const int tid0 = otid();
    if (bid == 0 && tid0 < 2) {
        const int l = tid0; const float* dl = p.diff_lambda + l * 128;
        float s1 = 0.f, s2 = 0.f;
        for (int i = 0; i < 32; ++i) { s1 += dl[i] * dl[32 + i]; s2 += dl[64 + i] * dl[96 + i]; }
        const float lam_init = l == 0 ? 0.2f : 0.35550906759096926f;
        p.LAM[l] = __expf(s1) - __expf(s2) + lam_init;
    }
    for (int k = 0; k < (288 + G - 1) / G; ++k) { int it = bid + k * G; if (it >= 288) it = 287; mod_item(p, it, smem); }
    for (int it = bid; it < 1536; it += G) rope_item(p, it);
    for (int k = 0; k < (2 * 5184 + G - 1) / G; ++k) {
        int it = bid + k * G; if (it >= 2 * 5184) it = 2 * 5184 - 1;
        const int l = it / 5184; int r = it % 5184;
        const float* src; bf16_t* dst = p.WB + (size_t)l * W_LAYER; int K, N, kind, ntn;
        if (r < 1408) { src = p.ffn1_wi + (size_t)l * 1024 * 5632; dst += W_WI1; K = 1024; N = 5632; kind = 1; ntn = 88; }
        else if ((r -= 1408) < 704) { src = p.ffn1_wo + (size_t)l * 2816 * 1024; dst += W_WO1; K = 2816; N = 1024; kind = 0; ntn = 16; }
        else if ((r -= 704) < 1408) { src = p.ffn2_wi + (size_t)l * 1024 * 5632; dst += W_WI2; K = 1024; N = 5632; kind = 1; ntn = 88; }
        else if ((r -= 1408) < 704) { src = p.ffn2_wo + (size_t)l * 2816 * 1024; dst += W_WO2; K = 2816; N = 1024; kind = 0; ntn = 16; }
        else if ((r -= 704) < 704) { src = p.w_in + (size_t)l * 1024 * 2576; dst += W_WIN; K = 1024; N = 2576; kind = 2; ntn = 44; }
        else { r -= 704; src = p.w_out + (size_t)l * 1024 * 1024; dst += W_WOUT; K = 1024; N = 1024; kind = 0; ntn = 16; }
        convert_tile(src, K, N, dst, kind, r % ntn, r / ntn, (float*)smem);
    }
}

DI void ln_phase(const Params& p, int mode, const float* g, const float* bb, const float* modl, int s_next, int nrows) {
    const int tid_ = otid(); const int lane = tid_ & 63, wave = tid_ >> 6;
    const int bid_ = obid(), G_ = ogrid();
    const int stride = G_ * 4;
    float4 g4[4], b4[4];
#pragma unroll
    for (int i = 0; i < 4; ++i) { g4[i] = make_float4(1.f, 1.f, 1.f, 1.f); b4[i] = make_float4(0.f, 0.f, 0.f, 0.f); }
    if (mode != 0) {
#pragma unroll
        for (int i = 0; i < 4; ++i) { g4[i] = ((const float4*)g)[lane + 64 * i]; b4[i] = ((const float4*)bb)[lane + 64 * i]; }
    }
    int row = bid_ * 4 + wave;
    float4 nxt[4];
    if (row < nrows) {
        const float* src = mode == 0 ? (row < NL ? p.x + (size_t)row * DM : p.ctx + (size_t)(row - NL) * DM) : xrow_ptr(p, row);
#pragma unroll
        for (int i = 0; i < 4; ++i) nxt[i] = ((const float4*)src)[lane + 64 * i];
    }
    for (; row < nrows; row += stride) {
        float* dst = xrow_ptr(p, row);
        float v[16];
#pragma unroll
        for (int i = 0; i < 4; ++i) { v[4 * i] = nxt[i].x; v[4 * i + 1] = nxt[i].y; v[4 * i + 2] = nxt[i].z; v[4 * i + 3] = nxt[i].w; }
        const int rown = row + stride;
        if (rown < nrows) {
            const float* srcn = mode == 0 ? (rown < NL ? p.x + (size_t)rown * DM : p.ctx + (size_t)(rown - NL) * DM) : xrow_ptr(p, rown);
#pragma unroll
            for (int i = 0; i < 4; ++i) nxt[i] = ((const float4*)srcn)[lane + 64 * i];
        }
        float4 sh4[4], sc4[4];
        if (mode != 2) {
            const float* mrow = modl + (size_t)(row < NL ? (row >> 13) : 8) * 9216;
            const float4* sh = (const float4*)(mrow + (3 * s_next) * 1024);
            const float4* sc = (const float4*)(mrow + (3 * s_next + 1) * 1024);
#pragma unroll
            for (int i = 0; i < 4; ++i) { sh4[i] = sh[lane + 64 * i]; sc4[i] = sc[lane + 64 * i]; }
        }
        __builtin_amdgcn_sched_barrier(0);
        if (mode != 0) {
            float s = 0.f;
#pragma unroll
            for (int i = 0; i < 16; ++i) s += v[i];
            const float mu = wave_sum(s, lane) * (1.f / DM);
            float q = 0.f;
#pragma unroll
            for (int i = 0; i < 16; ++i) { v[i] -= mu; q += v[i] * v[i]; }
            const float rs = rsqrtf(wave_sum(q, lane) * (1.f / DM) + EPSV);
            if (mode == 1 && lane == 0) *(f32x2*)(p.STATS + (size_t)row * 2) = (f32x2){mu, rs};
#pragma unroll
            for (int i = 0; i < 4; ++i) {
                v[4 * i] = v[4 * i] * rs * g4[i].x + b4[i].x; v[4 * i + 1] = v[4 * i + 1] * rs * g4[i].y + b4[i].y;
                v[4 * i + 2] = v[4 * i + 2] * rs * g4[i].z + b4[i].z; v[4 * i + 3] = v[4 * i + 3] * rs * g4[i].w + b4[i].w;
            }
        }
        if (mode == 2) {
#pragma unroll
            for (int i = 0; i < 4; ++i) ((float4*)dst)[lane + 64 * i] = make_float4(v[4 * i], v[4 * i + 1], v[4 * i + 2], v[4 * i + 3]);
        }
        if (mode != 2) {
            float s = 0.f;
#pragma unroll
            for (int i = 0; i < 16; ++i) s += v[i];
            const float mu = wave_sum(s, lane) * (1.f / DM);
            float q = 0.f;
#pragma unroll
            for (int i = 0; i < 16; ++i) { v[i] -= mu; q += v[i] * v[i]; }
            const float rs = rsqrtf(wave_sum(q, lane) * (1.f / DM) + EPSV);
            bf16_t* hrow = p.H + (size_t)row * DM;
#pragma unroll
            for (int i = 0; i < 4; ++i) {
                const float4 a = sh4[i], c4 = sc4[i];
                u32x2 w;
                w.x = pk_bf16(v[4 * i] * rs * (1.f + c4.x) + a.x, v[4 * i + 1] * rs * (1.f + c4.y) + a.y);
                w.y = pk_bf16(v[4 * i + 2] * rs * (1.f + c4.z) + a.z, v[4 * i + 3] * rs * (1.f + c4.w) + a.w);
                ((u32x2*)hrow)[lane + 64 * i] = w;
            }
        }
    }
}

struct EpiSwiglu {
    static constexpr bool TAIL = false;
    DI void tail(const f32x16&, int, int, int, int, const float*) const {}
    DI void prefetch(int, int, float*) const {}
    bf16_t* ACT;
    DI void operator()(const f32x16 (&acc)[2][2], int row0, int col0, int r, int h, const float*) const {
        const int hc = (col0 >> 1) + r;
#pragma unroll
        for (int mi = 0; mi < 2; ++mi)
#pragma unroll
            for (int i = 0; i < 16; ++i) {
                const int row = row0 + mi * 32 + crow(i, h);
                const float gt = acc[mi][0][i], up = acc[mi][1][i];
                ACT[(size_t)row * DFF + hc] = to_bf16(gt * __builtin_amdgcn_rcpf(1.f + __expf(-gt)) * up);
            }
    }
};
struct EpiResid {
    static constexpr bool TAIL = true;
    const Params* p; const float* modl; int midx; float gs; int from_input; const float* pg; const float* pb;
    DI void prefetch(int row_tile0, int tid, float* sst) const {
        if (!from_input && tid < 256) *(f32x2*)(sst + 2 * tid) = *(const f32x2*)(p->STATS + (size_t)(row_tile0 + tid) * 2);
    }
    DI void operator()(const f32x16 (&acc)[2][2], int row0, int col0, int r, int h, const float* sst) const {
        const float* mrow = modl + (size_t)(row0 < NL ? (row0 >> 13) : 8) * 9216 + midx * 1024;
        const float gm0 = gs * mrow[col0 + r], gm1 = gs * mrow[col0 + 32 + r];
        const size_t off = (size_t)(4 * h) * DM + col0 + r;
        float* base = xrow_ptr(*p, row0) + off;
        const float* rbase = from_input ? (row0 < NL ? p->x + (size_t)row0 * DM : p->ctx + (size_t)(row0 - NL) * DM) + off : base;
        float g0 = 1.f, g1 = 1.f, b0 = 0.f, b1 = 0.f;
        if (!from_input) { g0 = pg[col0 + r]; g1 = pg[col0 + 32 + r]; b0 = pb[col0 + r]; b1 = pb[col0 + 32 + r]; }
        float x0[2][16], x1[2][16];
#pragma unroll
        for (int mi = 0; mi < 2; ++mi)
#pragma unroll
            for (int i = 0; i < 16; ++i) {
                const float* xr = rbase + (size_t)(mi * 32 + (i & 3) + 8 * (i >> 2)) * DM;
                x0[mi][i] = xr[0]; x1[mi][i] = xr[32];
            }
#pragma unroll
        for (int mi = 0; mi < 2; ++mi)
#pragma unroll
            for (int i = 0; i < 16; ++i) {
                float* xp = base + (size_t)(mi * 32 + (i & 3) + 8 * (i >> 2)) * DM;
                float a0 = x0[mi][i], a1 = x1[mi][i];
                if (!from_input) {
                    const f32x2 st = *(const f32x2*)(sst + 2 * (mi * 32 + (i & 3) + 8 * (i >> 2) + 4 * h));
                    a0 = (a0 - st.x) * st.y * g0 + b0; a1 = (a1 - st.x) * st.y * g1 + b1;
                }
                xp[0] = ALPHA * a0 + gm0 * acc[mi][0][i];
                xp[32] = ALPHA * a1 + gm1 * acc[mi][1][i];
            }
    }
    DI void tail(const f32x16& acc, int row0, int col0, int r, int h, const float* sst) const {
        const float* mrow = modl + (size_t)(row0 < NL ? (row0 >> 13) : 8) * 9216 + midx * 1024;
        const float gm0 = gs * mrow[col0 + r];
        const size_t off = (size_t)(4 * h) * DM + col0 + r;
        float* base = xrow_ptr(*p, row0) + off;
        const float* rbase = from_input ? (row0 < NL ? p->x + (size_t)row0 * DM : p->ctx + (size_t)(row0 - NL) * DM) + off : base;
        float g0 = 1.f, b0 = 0.f;
        if (!from_input) { g0 = pg[col0 + r]; b0 = pb[col0 + r]; }
        float x0[16];
#pragma unroll
        for (int i = 0; i < 16; ++i) x0[i] = rbase[(size_t)((i & 3) + 8 * (i >> 2)) * DM];
#pragma unroll
        for (int i = 0; i < 16; ++i) {
            float a0 = x0[i];
            if (!from_input) { const f32x2 st = *(const f32x2*)(sst + 2 * ((i & 3) + 8 * (i >> 2) + 4 * h)); a0 = (a0 - st.x) * st.y * g0 + b0; }
            base[(size_t)((i & 3) + 8 * (i >> 2)) * DM] = ALPHA * a0 + gm0 * acc[i];
        }
    }
};
struct EpiProj {
    static constexpr bool TAIL = false;
    DI void tail(const f32x16&, int, int, int, int, const float*) const {}
    DI void prefetch(int, int, float*) const {}
    bf16_t* PROJ; float* GATES; const float* gate_b;
    DI void operator()(const f32x16 (&acc)[2][2], int row0, int col0, int r, int h, const float*) const {
#pragma unroll
        for (int ni = 0; ni < 2; ++ni) {
            const int cb = col0 + ni * 32, col = cb + r;
            if (cb < PW) {
#pragma unroll
                for (int mi = 0; mi < 2; ++mi)
#pragma unroll
                    for (int i = 0; i < 16; ++i) PROJ[(size_t)(row0 + mi * 32 + crow(i, h)) * PW + col] = to_bf16(acc[mi][ni][i]);
            } else if (cb == PW && r < 16) {
                const float gb = gate_b[r];
#pragma unroll
                for (int mi = 0; mi < 2; ++mi)
#pragma unroll
                    for (int i = 0; i < 16; ++i) GATES[(size_t)(row0 + mi * 32 + crow(i, h)) * 16 + r] = acc[mi][ni][i] + gb;
            }
        }
    }
};

template <class Epi>
DI void gemm_phase(const bf16_t* A, const bf16_t* Bt, int K, int mtiles, int ntiles, const Epi& epi, char* smem) {
    bf16_t* sA = (bf16_t*)smem;
    bf16_t* sB = sA + 2 * 256 * 72;
    const int tid = otid512(), lane = tid & 63, wave = tid >> 6, wr = wave >> 2, wc = wave & 3, r = lane & 31, h = lane >> 5;
    const int bid_ = rbid(), G_ = rgrid();
    const int xcd = bid_ & 7, local = bid_ >> 3, nloc = G_ >> 3;
    const int mper = mtiles >> 3, mrem = mtiles & 7;
    const int mbeg = xcd * mper + (xcd < mrem ? xcd : mrem), mcnt = mper + (xcd < mrem ? 1 : 0);
    const int total = mcnt * ntiles, pg = 4 * ntiles, nk = K >> 6;
    const int srow = tid >> 3, skc = (tid & 7) * 8;
    const int main_total = Epi::TAIL ? (total / nloc) * nloc : total;
    int tcount = 0;
    for (int it = local; it < main_total; it += nloc) {
        const int grp = it / pg, rem = it - grp * pg;
        const int gl = mcnt - grp * 4, gsz = gl < 4 ? gl : 4;
        const int mt = mbeg + grp * 4 + rem % gsz, nt = rem / gsz;
        const bf16_t* Ag = A + (size_t)(mt * 256 + srow) * K + skc;
        const bf16_t* Bg = Bt + (size_t)(nt * 256 + srow) * K + skc;
        float* sst = (float*)(smem + 2 * HALF_LDS) + (tcount & 1) * 512; ++tcount;
        epi.prefetch(mt * 256, tid, sst);
        u32x4 ra[4], rb[4];
#pragma unroll
        for (int i = 0; i < 4; ++i) { ra[i] = *(const u32x4*)(Ag + (size_t)(64 * i) * K); rb[i] = *(const u32x4*)(Bg + (size_t)(64 * i) * K); }
#pragma unroll
        for (int i = 0; i < 4; ++i) { *(u32x4*)(sA + (srow + 64 * i) * 72 + skc) = ra[i]; *(u32x4*)(sB + (srow + 64 * i) * 72 + skc) = rb[i]; }
#pragma unroll
        for (int i = 0; i < 4; ++i) { ra[i] = *(const u32x4*)(Ag + (size_t)(64 * i) * K + 64); rb[i] = *(const u32x4*)(Bg + (size_t)(64 * i) * K + 64); }
        __syncthreads();
        f32x16 acc[4][2];
#pragma unroll
        for (int a = 0; a < 4; ++a)
#pragma unroll
            for (int b = 0; b < 2; ++b)
#pragma unroll
                for (int i = 0; i < 16; ++i) acc[a][b][i] = 0.f;
        for (int kt = 0; kt < nk; ++kt) {
            const int cur = kt & 1;
            const bf16_t* a_ = sA + cur * 256 * 72 + (wr * 128 + r) * 72 + 8 * h;
            const bf16_t* b_ = sB + cur * 256 * 72 + (wc * 64 + r) * 72 + 8 * h;
            bf16_t* wa = sA + (cur ^ 1) * 256 * 72 + srow * 72 + skc; bf16_t* wb = sB + (cur ^ 1) * 256 * 72 + srow * 72 + skc;
#define GEMM_KS(ks) { const bf16x8 b0 = *(const bf16x8*)(b_ + (ks) * 16), b1 = *(const bf16x8*)(b_ + 32 * 72 + (ks) * 16); \
                bf16x8 af[4]; _Pragma("unroll") for (int mi = 0; mi < 4; ++mi) af[mi] = *(const bf16x8*)(a_ + mi * 32 * 72 + (ks) * 16); \
                __builtin_amdgcn_s_setprio(1); \
                _Pragma("unroll") for (int mi = 0; mi < 4; ++mi) { acc[mi][0] = MFMA32(af[mi], b0, acc[mi][0]); acc[mi][1] = MFMA32(af[mi], b1, acc[mi][1]); } \
                __builtin_amdgcn_s_setprio(0); }
            GEMM_KS(0) GEMM_KS(1)
            __builtin_amdgcn_sched_barrier(0);
            if (kt + 1 < nk) {
#pragma unroll
                for (int i = 0; i < 4; ++i) *(u32x4*)(wa + 64 * i * 72) = ra[i];
            }
            if (kt + 2 < nk) {
#pragma unroll
                for (int i = 0; i < 4; ++i) ra[i] = *(const u32x4*)(Ag + (size_t)(64 * i) * K + (kt + 2) * 64);
            }
            GEMM_KS(2)
            __builtin_amdgcn_sched_barrier(0);
            if (kt + 1 < nk) {
#pragma unroll
                for (int i = 0; i < 4; ++i) *(u32x4*)(wb + 64 * i * 72) = rb[i];
            }
            if (kt + 2 < nk) {
#pragma unroll
                for (int i = 0; i < 4; ++i) rb[i] = *(const u32x4*)(Bg + (size_t)(64 * i) * K + (kt + 2) * 64);
            }
            GEMM_KS(3)
#undef GEMM_KS
            __syncthreads();
        }
        epi(reinterpret_cast<const f32x16(&)[2][2]>(acc[0]), mt * 256 + wr * 128, nt * 256 + wc * 64, r, h, sst + 2 * (wr * 128));
        epi(reinterpret_cast<const f32x16(&)[2][2]>(acc[2]), mt * 256 + wr * 128 + 64, nt * 256 + wc * 64, r, h, sst + 2 * (wr * 128 + 64));
    }
    if (Epi::TAIL) {
        const int nunits = (total - main_total) * 8;
        bf16_t* tB = sB;
        const int brow = tid >> 3;
        for (int u = local; u < nunits; u += nloc) {
            const int it = main_total + (u >> 3), cs = u & 7;
            const int grp = it / pg, rem = it - grp * pg;
            const int gl = mcnt - grp * 4, gsz = gl < 4 ? gl : 4;
            const int mt = mbeg + grp * 4 + rem % gsz, nt = rem / gsz;
            const bf16_t* Ag = A + (size_t)(mt * 256 + srow) * K + skc;
            const bf16_t* Bg = Bt + (size_t)(nt * 256 + cs * 32 + (brow & 31)) * K + skc;
            float* sst = (float*)(smem + 2 * HALF_LDS) + (tcount & 1) * 512; ++tcount;
            epi.prefetch(mt * 256, tid, sst);
            u32x4 ra[4][4], rb[4];
            __syncthreads();
#pragma unroll
            for (int i = 0; i < 4; ++i) ra[0][i] = *(const u32x4*)(Ag + (size_t)(64 * i) * K);
            rb[0] = *(const u32x4*)(Bg);
#pragma unroll
            for (int i = 0; i < 4; ++i) *(u32x4*)(sA + (srow + 64 * i) * 72 + skc) = ra[0][i];
            if (tid < 256) *(u32x4*)(tB + brow * 72 + skc) = rb[0];
#pragma unroll
            for (int t = 1; t <= 4; ++t) {
#pragma unroll
                for (int i = 0; i < 4; ++i) ra[t & 3][i] = *(const u32x4*)(Ag + (size_t)(64 * i) * K + t * 64);
                rb[t & 3] = *(const u32x4*)(Bg + t * 64);
            }
            __syncthreads();
            f32x16 acc1;
#pragma unroll
            for (int i = 0; i < 16; ++i) acc1[i] = 0.f;
            for (int kq = 0; kq < nk; kq += 4) {
#pragma unroll
                for (int j = 0; j < 4; ++j) {
                    const int kt = kq + j, cur = kt & 1, slot = (j + 1) & 3;
                    if (kt + 1 < nk) {
#pragma unroll
                        for (int i = 0; i < 4; ++i) *(u32x4*)(sA + (cur ^ 1) * 256 * 72 + (srow + 64 * i) * 72 + skc) = ra[slot][i];
                        if (tid < 256) *(u32x4*)(tB + (cur ^ 1) * 32 * 72 + brow * 72 + skc) = rb[slot];
                    }
                    if (kt + 5 < nk) {
#pragma unroll
                        for (int i = 0; i < 4; ++i) ra[slot][i] = *(const u32x4*)(Ag + (size_t)(64 * i) * K + (kt + 5) * 64);
                        rb[slot] = *(const u32x4*)(Bg + (kt + 5) * 64);
                    }
                    const bf16_t* a_ = sA + cur * 256 * 72 + (wave * 32 + r) * 72 + 8 * h;
                    const bf16_t* b_ = tB + cur * 32 * 72 + r * 72 + 8 * h;
#pragma unroll
                    for (int ks = 0; ks < 4; ++ks) acc1 = MFMA32(*(const bf16x8*)(a_ + ks * 16), *(const bf16x8*)(b_ + ks * 16), acc1);
                    __syncthreads();
                }
            }
            epi.tail(acc1, mt * 256 + wave * 32, nt * 256 + cs * 32, r, h, sst + 2 * (wave * 32));
        }
    }
}

DI size_t seq_row(int b, int ctile64) {
    return ctile64 < 4 ? (size_t)NL + b * CTXL + ctile64 * 64 : (size_t)b * SEQL + (ctile64 - 4) * 64;
}
DI void prepkv_item(const Params& p, int layer, int item, char* smem) {
    const int hsel = item % 6, kt = (item / 6) % NCH, b = item / (6 * NCH);
    const int tid = otid(), key = tid >> 2, sub = tid & 3;
    const size_t row0 = seq_row(b, kt);
    const bf16_t* prow = p.ACT + (row0 + key) * PW;
    const bool lat = kt >= 4;
    const int t = (kt - 4) * 64 + key;
    int vcol;
    if (hsel < 4) {
        const int m = sub >> 1, g = sub & 1;
        const int cb = 256 + hsel * 64 + m * 32 + 8 * g;
        float lo[8], hi[8];
        unpack8(*(const u32x4*)(prow + cb), lo); unpack8(*(const u32x4*)(prow + cb + 16), hi);
        if (lat) {
            const float* tab = p.ROPEA + ((size_t)t * 16 + 8 * g) * 2;
#pragma unroll
            for (int j = 0; j < 8; ++j) { const float c = tab[2 * j], s = tab[2 * j + 1]; const float a = lo[j], bq = hi[j]; lo[j] = a * c - bq * s; hi[j] = bq * c + a * s; }
        }
        bf16_t* kd = p.KA + ((size_t)(b * 4 + hsel) * NKEY + kt * 64 + key) * 64 + m * 32 + 8 * g;
        *(u32x4*)kd = pack8(lo); *(u32x4*)(kd + 16) = pack8(hi);
        vcol = 512 + hsel * 64;
    } else {
        const int kv = hsel - 4, g = sub;
        const int cb = 2304 + kv * 64 + 8 * g;
        float lo[8], hi[8];
        unpack8(*(const u32x4*)(prow + cb), lo); unpack8(*(const u32x4*)(prow + cb + 32), hi);
        float ss = 0.f;
#pragma unroll
        for (int j = 0; j < 8; ++j) ss += lo[j] * lo[j] + hi[j] * hi[j];
        ss += shx(ss, tid & 63, 1); ss += shx(ss, tid & 63, 2);
        const float rs = rsqrtf(ss * (1.f / 64.f) + EPSV);
        const float* kg = p.kng + layer * 64;
#pragma unroll
        for (int j = 0; j < 8; ++j) { lo[j] *= rs * kg[8 * g + j]; hi[j] *= rs * kg[32 + 8 * g + j]; }
        if (lat) {
            const float* tab = p.ROPED + ((size_t)t * 32 + 8 * g) * 2;
#pragma unroll
            for (int j = 0; j < 8; ++j) { const float c = tab[2 * j], s = tab[2 * j + 1]; const float a = lo[j], bq = hi[j]; lo[j] = a * c - bq * s; hi[j] = bq * c + a * s; }
        }
        bf16_t* kd = p.KD + ((size_t)(b * 2 + kv) * NKEY + kt * 64 + key) * 64 + 8 * g;
        *(u32x4*)kd = pack8(lo); *(u32x4*)(kd + 32) = pack8(hi);
        vcol = 2432 + kv * 64;
    }
    bf16_t* sT = (bf16_t*)smem;
    {
        const int k2 = tid >> 2, c0 = (tid & 3) * 16;
        const u32x4 w0 = *(const u32x4*)(p.ACT + (row0 + k2) * PW + vcol + c0), w1 = *(const u32x4*)(p.ACT + (row0 + k2) * PW + vcol + c0 + 8);
        unsigned* d = (unsigned*)(sT + k2 * 66 + c0);
        d[0] = w0.x; d[1] = w0.y; d[2] = w0.z; d[3] = w0.w; d[4] = w1.x; d[5] = w1.y; d[6] = w1.z; d[7] = w1.w;
    }
    __syncthreads();
    {
        const int dv = tid >> 2, kq = (tid & 3) * 16;
        unsigned w[8];
#pragma unroll
        for (int j = 0; j < 8; ++j) w[j] = (unsigned)sT[(kq + 2 * j) * 66 + dv] | ((unsigned)sT[(kq + 2 * j + 1) * 66 + dv] << 16);
        bf16_t* vd = (hsel < 4 ? p.VTA + ((size_t)(b * 4 + hsel) * 64 + dv) * NKEY : p.VTD + ((size_t)(b * 2 + hsel - 4) * 64 + dv) * NKEY) + kt * 64 + kq;
        *(u32x4*)vd = (u32x4){w[0], w[1], w[2], w[3]};
        *(u32x4*)(vd + 8) = (u32x4){w[4], w[5], w[6], w[7]};
    }
    __syncthreads();
}

DI void pool_item(const Params& p, int layer, int seq, int tile, int g, char* smem) {
    float* su = (float*)smem;
    float* sd = su + 80 * 64;
    float* sw = sd + 64 * 68;
    const int tid = otid();
    const bool isctx = seq >= 8; const int b = seq & 7;
    const int Ls = isctx ? CTXL : SEQL;
    const size_t rbase = isctx ? (size_t)NL + b * CTXL : (size_t)b * SEQL;
    const int t0 = tile * 64, w2 = 1 << g;
    {
        u32x4 uch[3]; float wv[16];
        const float* pw = p.pool_w + ((size_t)layer * 4 + g) * 4096;
#pragma unroll
        for (int i = 0; i < 3; ++i) {
            const int c = tid + THREADS * i, rr = c >> 3, c8 = (c & 7) * 8, t = t0 - 8 + rr;
            uch[i] = (u32x4){0u, 0u, 0u, 0u};
            if (c < 640 && t >= 0 && t < Ls) uch[i] = *(const u32x4*)(p.ACT + (rbase + t) * PW + 768 + g * 64 + c8);
        }
#pragma unroll
        for (int i = 0; i < 16; ++i) wv[i] = pw[tid + THREADS * i];
#pragma unroll
        for (int i = 0; i < 3; ++i) {
            const int c = tid + THREADS * i, rr = c >> 3, c8 = (c & 7) * 8;
            if (c < 640) { float f[8]; unpack8(uch[i], f);
#pragma unroll
                for (int j = 0; j < 8; ++j) su[rr * 64 + c8 + j] = f[j]; }
        }
#pragma unroll
        for (int i = 0; i < 16; ++i) sw[tid + THREADS * i] = wv[i];
    }
    __syncthreads();
    const int e = tid & 63, tq = tid >> 6;
#pragma unroll 4
    for (int i = 0; i < 16; ++i) {
        const int tt = tq * 16 + i, t = t0 + tt;
        const int lo = t - w2 < 0 ? 0 : t - w2, hi = t + w2 > Ls ? Ls : t + w2;
        float s = 0.f;
        for (int q = lo; q < hi; ++q) s += su[(q - t0 + 8) * 64 + e];
        sd[tt * 68 + e] = s * __builtin_amdgcn_rcpf((float)(hi - lo)) - su[(tt + 8) * 64 + e];
    }
    __syncthreads();
    float acc[16];
#pragma unroll
    for (int i = 0; i < 16; ++i) acc[i] = 0.f;
#pragma unroll 1
    for (int c4 = 0; c4 < 16; ++c4) {
        const float w0 = sw[(4 * c4) * 64 + e], w1 = sw[(4 * c4 + 1) * 64 + e], w2_ = sw[(4 * c4 + 2) * 64 + e], w3 = sw[(4 * c4 + 3) * 64 + e];
#pragma unroll
        for (int i = 0; i < 16; ++i) { const float4 d = *(const float4*)(sd + (tq * 16 + i) * 68 + 4 * c4); acc[i] += d.x * w0 + d.y * w1 + d.z * w2_ + d.w * w3; }
    }
    const float ps = p.pool_scale[layer * 256 + g * 64 + e];
#pragma unroll
    for (int i = 0; i < 16; ++i) p.H[(rbase + t0 + tq * 16 + i) * DM + 256 + g * 64 + e] = to_bf16(acc[i] * ps);
    __syncthreads();
}

DI float log_sigmoid(float x) { return fminf(x, 0.f) - __logf(1.f + __expf(-fabsf(x))); }
DI void ml_gates(const Params& p, size_t row0, int head, float* sg) {
    const int tidg = otid();
    if (tidg < 64) {
        const int lane = tidg;
        const float* gp = p.GATES + (row0 + lane) * 16 + head;
        const float lif = gp[0], lff = log_sigmoid(gp[4]), lib = gp[8], lfb = log_sigmoid(gp[12]);
        float vf = lff, vb = lfb;
#pragma unroll
        for (int o = 1; o < 64; o <<= 1) {
            const float tf = shl(vf, lane - o), tb = shl(vb, lane + o);
            if (lane >= o) vf += tf;
            if (lane + o < 64) vb += tb;
        }
        sg[lane] = vf; sg[64 + lane] = lif; sg[128 + lane] = vb; sg[192 + lane] = lib;
    }
}
DI int chain_pos(int dir, int c) { return dir == 0 ? c : (c < 4 ? 3 - c : 4 + (131 - c)); }

DI void ml1_item(const Params& p, int item, char* smem) {
    float* sk = (float*)smem;
    float* sv = sk + 4096;
    float* sg = sv + 4096;
    float* swt = sg + 256;
    const int c = item % NCH, head = (item / NCH) & 3, b = item / (NCH * 4);
    const int tid = otid();
    const size_t row0 = seq_row(b, c);
    {
        u32x4 kk[2], vv[2];
#pragma unroll
        for (int i = 0; i < 2; ++i) {
            const int q = tid + THREADS * i, rr = q >> 3, c8 = (q & 7) * 8;
            kk[i] = *(const u32x4*)(p.ACT + (row0 + rr) * PW + 1280 + head * 64 + c8);
            vv[i] = *(const u32x4*)(p.ACT + (row0 + rr) * PW + 1536 + head * 64 + c8);
        }
#pragma unroll
        for (int i = 0; i < 2; ++i) {
            const int q = tid + THREADS * i, rr = q >> 3, c8 = (q & 7) * 8; float f[8];
            unpack8(kk[i], f);
#pragma unroll
            for (int j = 0; j < 8; ++j) sk[rr * 64 + c8 + j] = f[j];
            unpack8(vv[i], f);
#pragma unroll
            for (int j = 0; j < 8; ++j) sv[rr * 64 + c8 + j] = f[j];
        }
    }
    ml_gates(p, row0, head, sg);
    __syncthreads();
    if (tid < 64) { swt[tid] = __expf(sg[63] - sg[tid] + sg[64 + tid]); swt[64 + tid] = __expf(sg[128] - sg[128 + tid] + sg[192 + tid]); }
    __syncthreads();
    const int e = tid & 63, vq = tid >> 6;
    float af[16], ab[16], nf = 0.f, nb = 0.f;
#pragma unroll
    for (int i = 0; i < 16; ++i) { af[i] = 0.f; ab[i] = 0.f; }
#pragma unroll 2
    for (int t = 0; t < 64; ++t) {
        const float kk = sk[t * 64 + e], kf = kk * swt[t], kb = kk * swt[64 + t];
        nf += kf; nb += kb;
#pragma unroll
        for (int i4 = 0; i4 < 4; ++i4) {
            const float4 vv = *(const float4*)(sv + t * 64 + vq * 16 + 4 * i4);
            af[4 * i4] += vv.x * kf; af[4 * i4 + 1] += vv.y * kf; af[4 * i4 + 2] += vv.z * kf; af[4 * i4 + 3] += vv.w * kf;
            ab[4 * i4] += vv.x * kb; ab[4 * i4 + 1] += vv.y * kb; ab[4 * i4 + 2] += vv.z * kb; ab[4 * i4 + 3] += vv.w * kb;
        }
    }
    const size_t chf = ((size_t)(b * 4 + head) * 2 + 0) * NCH + chain_pos(0, c), chb = ((size_t)(b * 4 + head) * 2 + 1) * NCH + chain_pos(1, c);
    bf16_t* df = p.ST + chf * STSZ; bf16_t* db = p.ST + chb * STSZ;
#pragma unroll
    for (int i = 0; i < 16; ++i) { df[(vq * 16 + i) * 64 + e] = to_bf16(af[i]); db[(vq * 16 + i) * 64 + e] = to_bf16(ab[i]); }
    if (vq == 0) { df[4096 + e] = to_bf16(nf); db[4096 + e] = to_bf16(nb); }
    if (tid == 0) { p.DEC[chf] = __expf(sg[63]); p.DEC[chb] = __expf(sg[128]); }
    __syncthreads();
}
DI void scan_item(const Params& p, int item) {
    const int chain = item / 9, wd = (item % 9) * THREADS + otid();
    if (wd >= STSZ / 2) return;
    unsigned* st = (unsigned*)(p.ST + (size_t)chain * NCH * STSZ) + wd;
    const float* dec = p.DEC + chain * NCH;
    float S0 = 0.f, S1 = 0.f;
    for (int q0 = 0; q0 < NCH; q0 += 22) {
        unsigned tmp[22]; float dd[22];
#pragma unroll
        for (int i = 0; i < 22; ++i) { tmp[i] = st[(size_t)(q0 + i) * (STSZ / 2)]; dd[i] = dec[q0 + i]; }
#pragma unroll
        for (int i = 0; i < 22; ++i) { st[(size_t)(q0 + i) * (STSZ / 2)] = pk_bf16(S0, S1); S0 = dd[i] * S0 + bflo(tmp[i]); S1 = dd[i] * S1 + bfhi(tmp[i]); }
    }
}
DI void ml3_pair(const Params& p, int layer, int it2, int cpc, int n5, int last, char* smem) {
    const int tid = otid(), lane = tid & 63, wave = tid >> 6, pr = wave >> 1, jw = wave & 1, r = lane & 31, h = lane >> 5, t2 = tid & 127;
    int idx = 2 * it2 + pr; if (idx >= n5) idx = n5 - 1;
    const int item = (idx / cpc) * NCH + (last ? 4 : 0) + idx % cpc;
    const int c = item % NCH, head = (item / NCH) & 3, b = item / (NCH * 4);
    const size_t row0 = seq_row(b, c);
    char* slot = smem + pr * 36864;
    bf16_t* sKb = (bf16_t*)slot;
    bf16_t* sVt = sKb + 64 * 72;
    bf16_t* sC = sVt + 64 * 68;
    float* sg = (float*)(sC + 64 * 72);
    float* sn = sg + 256;
    {
        u32x4 kq[4], vq[4];
#pragma unroll
        for (int i = 0; i < 4; ++i) {
            const int cc = t2 + 128 * i, row = cc >> 3, c8 = (cc & 7) * 8;
            const bf16_t* src = p.ACT + (row0 + row) * PW + head * 64 + c8;
            kq[i] = *(const u32x4*)(src + 1280); vq[i] = *(const u32x4*)(src + 1536);
        }
        __builtin_amdgcn_sched_barrier(0);
#pragma unroll
        for (int i = 0; i < 4; ++i) {
            const int cc = t2 + 128 * i, row = cc >> 3, c8 = (cc & 7) * 8;
            *(u32x4*)(sKb + row * 72 + c8) = kq[i];
            const u32x4 vv = vq[i];
            sVt[(c8 + 0) * 68 + row] = (bf16_t)(vv.x & 0xffffu); sVt[(c8 + 1) * 68 + row] = (bf16_t)(vv.x >> 16);
            sVt[(c8 + 2) * 68 + row] = (bf16_t)(vv.y & 0xffffu); sVt[(c8 + 3) * 68 + row] = (bf16_t)(vv.y >> 16);
            sVt[(c8 + 4) * 68 + row] = (bf16_t)(vv.z & 0xffffu); sVt[(c8 + 5) * 68 + row] = (bf16_t)(vv.z >> 16);
            sVt[(c8 + 6) * 68 + row] = (bf16_t)(vv.w & 0xffffu); sVt[(c8 + 7) * 68 + row] = (bf16_t)(vv.w >> 16);
        }
    }
    const size_t chf = ((size_t)(b * 4 + head) * 2 + 0) * NCH + chain_pos(0, c), chb = ((size_t)(b * 4 + head) * 2 + 1) * NCH + chain_pos(1, c);
    if (jw == 0) {
        const float* gp = p.GATES + (row0 + lane) * 16 + head;
        const float lif = gp[0], lff = log_sigmoid(gp[4]), lib = gp[8], lfb = log_sigmoid(gp[12]);
        float vf = lff, vb = lfb;
#pragma unroll
        for (int o = 1; o < 64; o <<= 1) {
            const float tf = shl(vf, lane - o), tb = shl(vb, lane + o);
            if (lane >= o) vf += tf;
            if (lane + o < 64) vb += tb;
        }
        sg[lane] = vf; sg[64 + lane] = lif - vf; sg[128 + lane] = vb; sg[192 + lane] = lib - vb;
    } else {
        sn[lane] = bf2f(p.ST[chf * STSZ + 4096 + lane]); sn[64 + lane] = bf2f(p.ST[chb * STSZ + 4096 + lane]);
    }
    const int j = 32 * jw + r;
    const bf16_t* qp = p.ACT + (row0 + j) * PW + 1024 + head * 64 + 8 * h;
    bf16x8 qf[4];
#pragma unroll
    for (int ks = 0; ks < 4; ++ks) qf[ks] = __builtin_bit_cast(bf16x8, *(const u32x4*)(qp + 16 * ks));
    f32x16 hs[2];
#pragma unroll
    for (int d = 0; d < 2; ++d)
#pragma unroll
        for (int i = 0; i < 16; ++i) hs[d][i] = 0.f;
#pragma unroll 1
    for (int dir = 0; dir < 2; ++dir) {
        __syncthreads();
        {
            const bf16_t* st = p.ST + (dir == 0 ? chf : chb) * STSZ;
            u32x4 cf[4];
#pragma unroll
            for (int i = 0; i < 4; ++i) { const int cc = t2 + 128 * i, v = cc >> 3, e8 = (cc & 7) * 8; cf[i] = *(const u32x4*)(st + v * 64 + e8); }
#pragma unroll
            for (int i = 0; i < 4; ++i) { const int cc = t2 + 128 * i, v = cc >> 3, e8 = (cc & 7) * 8; *(u32x4*)(sC + v * 72 + e8) = cf[i]; }
        }
        __syncthreads();
        const float* bc = sg + dir * 128; const float* bl = bc + 64; const float* nn = sn + dir * 64;
        float nq = 0.f;
#pragma unroll
        for (int ks = 0; ks < 4; ++ks) {
            float qv[8]; unpack8(__builtin_bit_cast(u32x4, qf[ks]), qv);
#pragma unroll
            for (int jj = 0; jj < 8; ++jj) nq += qv[jj] * nn[16 * ks + 8 * h + jj];
        }
        nq += shx(nq, lane, 32);
        f32x16 x[2];
#pragma unroll
        for (int kb = 0; kb < 2; ++kb)
#pragma unroll
            for (int i = 0; i < 16; ++i) x[kb][i] = 0.f;
#pragma unroll
        for (int ks = 0; ks < 4; ++ks) {
            const bf16x8 a0 = *(const bf16x8*)(sKb + r * 72 + 16 * ks + 8 * h), a1 = *(const bf16x8*)(sKb + (32 + r) * 72 + 16 * ks + 8 * h);
            x[0] = MFMA32(a0, qf[ks], x[0]); x[1] = MFMA32(a1, qf[ks], x[1]);
        }
        const float bcj = bc[j];
        float den = 0.f;
#pragma unroll
        for (int kb = 0; kb < 2; ++kb)
#pragma unroll
            for (int i = 0; i < 16; ++i) {
                const int k = 32 * kb + crow(i, h);
                const bool ok = dir == 0 ? (k <= j) : (k >= j);
                const float w = ok ? 0.125f * x[kb][i] * __expf(bcj + bl[k]) : 0.f;
                x[kb][i] = w; den += w;
            }
        den += shx(den, lane, 32);
        f32x16 num[2], ci[2];
#pragma unroll
        for (int d = 0; d < 2; ++d)
#pragma unroll
            for (int i = 0; i < 16; ++i) { num[d][i] = 0.f; ci[d][i] = 0.f; }
#pragma unroll
        for (int kb = 0; kb < 2; ++kb)
#pragma unroll
            for (int st = 0; st < 2; ++st) {
                u32x4 w;
                w.x = pk_bf16(x[kb][8 * st], x[kb][8 * st + 1]); w.y = pk_bf16(x[kb][8 * st + 2], x[kb][8 * st + 3]);
                w.z = pk_bf16(x[kb][8 * st + 4], x[kb][8 * st + 5]); w.w = pk_bf16(x[kb][8 * st + 6], x[kb][8 * st + 7]);
                const bf16x8 pfr = __builtin_bit_cast(bf16x8, w);
#pragma unroll
                for (int d = 0; d < 2; ++d) {
                    const bf16_t* vp = sVt + (32 * d + r) * 68 + 32 * kb + 16 * st + 4 * h;
                    const s16x4 lo = *(const s16x4*)vp, hi = *(const s16x4*)(vp + 8);
                    const bf16x8 vf = __builtin_shufflevector(lo, hi, 0, 1, 2, 3, 4, 5, 6, 7);
                    num[d] = MFMA32(vf, pfr, num[d]);
                }
            }
#pragma unroll
        for (int ks = 0; ks < 4; ++ks)
#pragma unroll
            for (int d = 0; d < 2; ++d) {
                const bf16x8 cf = *(const bf16x8*)(sC + (32 * d + r) * 72 + 16 * ks + 8 * h);
                ci[d] = MFMA32(cf, qf[ks], ci[d]);
            }
        const float wi = 0.125f * __expf(bcj);
        const float inv = 1.f / fmaxf(fabsf(den + wi * nq), 1.f);
#pragma unroll
        for (int d = 0; d < 2; ++d)
#pragma unroll
            for (int i = 0; i < 16; ++i) hs[d][i] += (num[d][i] + wi * ci[d][i]) * inv;
    }
    float ss = 0.f;
#pragma unroll
    for (int d = 0; d < 2; ++d)
#pragma unroll
        for (int i = 0; i < 16; ++i) ss += hs[d][i] * hs[d][i];
    ss += shx(ss, lane, 32);
    const float rs = rsqrtf(ss * (1.f / 64.f) + EPSV);
    const float* gm = p.ml_norm_g + layer * 256 + head * 64;
    const bf16_t* op = p.ACT + (row0 + j) * PW + 1792 + head * 64;
    bf16_t* outp = p.H + (row0 + j) * DM + 512 + head * 64;
    u32x2 owv[2][4]; float gmv[2][16];
#pragma unroll
    for (int d = 0; d < 2; ++d)
#pragma unroll
        for (int ig = 0; ig < 4; ++ig) {
            const int v0 = 32 * d + 8 * ig + 4 * h;
            owv[d][ig] = *(const u32x2*)(op + v0);
#pragma unroll
            for (int jj = 0; jj < 4; ++jj) gmv[d][4 * ig + jj] = gm[v0 + jj];
        }
#pragma unroll
    for (int d = 0; d < 2; ++d)
#pragma unroll
        for (int ig = 0; ig < 4; ++ig) {
            const int v0 = 32 * d + 8 * ig + 4 * h;
            const u32x2 ow = owv[d][ig];
            const float o0 = bflo(ow.x), o1 = bfhi(ow.x), o2 = bflo(ow.y), o3 = bfhi(ow.y);
            u32x2 w;
            w.x = pk_bf16(hs[d][4 * ig] * rs * gmv[d][4 * ig] * __builtin_amdgcn_rcpf(1.f + __expf(-o0)), hs[d][4 * ig + 1] * rs * gmv[d][4 * ig + 1] * __builtin_amdgcn_rcpf(1.f + __expf(-o1)));
            w.y = pk_bf16(hs[d][4 * ig + 2] * rs * gmv[d][4 * ig + 2] * __builtin_amdgcn_rcpf(1.f + __expf(-o2)), hs[d][4 * ig + 3] * rs * gmv[d][4 * ig + 3] * __builtin_amdgcn_rcpf(1.f + __expf(-o3)));
            *(u32x2*)(outp + v0) = w;
        }
    __syncthreads();
}

template <int DK>
DI void attn_item(const Params& p, int layer, int b, int hd, int qt, int ctxq, char* smem) {
    constexpr int NH = DK == 32 ? 4 : 2, NKS = DK / 16;
    bf16_t* sK = (bf16_t*)smem;
    bf16_t* sV = sK + 2 * 64 * 72;
    const int tid = otid(), lane = tid & 63, wave = tid >> 6, r = lane & 31, h = lane >> 5;
    const bf16_t* Kg = (DK == 32 ? p.KA : p.KD) + (size_t)(b * NH + hd) * NKEY * 64;
    const bf16_t* Vg = (DK == 32 ? p.VTA : p.VTD) + (size_t)(b * NH + hd) * 64 * NKEY;
    const int nkt = ctxq ? 4 : NCH;
    const int ql = qt * 128 + wave * 32 + r;
    const size_t prow = ctxq ? (size_t)NL + b * CTXL + ql : (size_t)b * SEQL + ql;
    const bf16_t* qp = p.ACT + prow * PW;
    const int srow = tid >> 3, sc8 = (tid & 7) * 8;
    u32x4 rk[2], rv[2];
#pragma unroll
    for (int i = 0; i < 2; ++i) { rk[i] = *(const u32x4*)(Kg + (size_t)(srow + 32 * i) * 64 + sc8); rv[i] = *(const u32x4*)(Vg + (size_t)(srow + 32 * i) * NKEY + sc8); }
    __builtin_amdgcn_sched_barrier(0);
    bf16x8 qf[2][NKS];
    if (DK == 32) {
        const float qs = 0.17677669529663687f * 1.4426950408889634f;
#pragma unroll
        for (int s = 0; s < 2; ++s) {
            float lo[8], hi[8];
            unpack8(*(const u32x4*)(qp + hd * 64 + 32 * s + 8 * h), lo); unpack8(*(const u32x4*)(qp + hd * 64 + 32 * s + 16 + 8 * h), hi);
            if (!ctxq) {
                const float* tab = p.ROPEA + ((size_t)ql * 16 + 8 * h) * 2;
#pragma unroll
                for (int j = 0; j < 8; ++j) { const float c = tab[2 * j], sn = tab[2 * j + 1]; const float a = lo[j], bq = hi[j]; lo[j] = a * c - bq * sn; hi[j] = bq * c + a * sn; }
            }
#pragma unroll
            for (int j = 0; j < 8; ++j) { lo[j] *= qs; hi[j] *= qs; }
            qf[s][0] = __builtin_bit_cast(bf16x8, pack8(lo)); qf[s][1 % NKS] = __builtin_bit_cast(bf16x8, pack8(hi));
        }
    } else {
        const float qs = 0.125f * 1.4426950408889634f;
        const float* qg = p.qng + layer * 64;
#pragma unroll
        for (int s = 0; s < 2; ++s) {
            float xv[4][8];
            float ss = 0.f;
#pragma unroll
            for (int ks = 0; ks < 4; ++ks) { unpack8(*(const u32x4*)(qp + 2048 + hd * 128 + s * 64 + 16 * ks + 8 * h), xv[ks]);
#pragma unroll
                for (int j = 0; j < 8; ++j) ss += xv[ks][j] * xv[ks][j]; }
            ss += shx(ss, lane, 32);
            const float rs = rsqrtf(ss * (1.f / 64.f) + EPSV);
#pragma unroll
            for (int ks = 0; ks < 4; ++ks)
#pragma unroll
                for (int j = 0; j < 8; ++j) xv[ks][j] *= rs * qg[16 * ks + 8 * h + j];
            if (!ctxq) {
#pragma unroll
                for (int ks = 0; ks < 2; ++ks) {
                    const float* tab = p.ROPED + ((size_t)ql * 32 + 16 * ks + 8 * h) * 2;
#pragma unroll
                    for (int j = 0; j < 8; ++j) { const float c = tab[2 * j], sn = tab[2 * j + 1]; const float a = xv[ks][j], bq = xv[ks + 2][j]; xv[ks][j] = a * c - bq * sn; xv[ks + 2][j] = bq * c + a * sn; }
                }
            }
#pragma unroll
            for (int ks = 0; ks < 4; ++ks) {
#pragma unroll
                for (int j = 0; j < 8; ++j) xv[ks][j] *= qs;
                qf[s][ks % NKS] = __builtin_bit_cast(bf16x8, pack8(xv[ks]));
            }
        }
    }
    bf16_t* sQ = sV + 2 * 64 * 68 + wave * (2 * NKS * 64 * 8);
#pragma unroll
    for (int s = 0; s < 2; ++s)
#pragma unroll
        for (int ks = 0; ks < NKS; ++ks) *(bf16x8*)(sQ + ((s * NKS + ks) * 64 + lane) * 8) = qf[s][ks];
    float m_[2] = {-1e30f, -1e30f}, l_[2] = {0.f, 0.f};
    f32x16 O[2][2];
#pragma unroll
    for (int s = 0; s < 2; ++s)
#pragma unroll
        for (int d = 0; d < 2; ++d)
#pragma unroll
            for (int i = 0; i < 16; ++i) O[s][d][i] = 0.f;
#pragma unroll
    for (int i = 0; i < 2; ++i) {
        *(u32x4*)(sK + (srow + 32 * i) * 72 + sc8) = rk[i];
        *(u32x2*)(sV + (srow + 32 * i) * 68 + sc8) = (u32x2){rv[i].x, rv[i].y}; *(u32x2*)(sV + (srow + 32 * i) * 68 + sc8 + 4) = (u32x2){rv[i].z, rv[i].w};
    }
    __syncthreads();
    for (int kt = 0; kt < nkt; ++kt) {
        const int cur = kt & 1;
        const bf16_t* kb_ = sK + cur * 64 * 72; const bf16_t* vb_ = sV + cur * 64 * 68;
#pragma unroll
        for (int s = 0; s < 2; ++s) {
            if (s == 1) {
                if (kt + 1 < nkt) {
#pragma unroll
                    for (int i = 0; i < 2; ++i) { rk[i] = *(const u32x4*)(Kg + (size_t)((kt + 1) * 64 + srow + 32 * i) * 64 + sc8); rv[i] = *(const u32x4*)(Vg + (size_t)(srow + 32 * i) * NKEY + (kt + 1) * 64 + sc8); }
                }
            }
            f32x16 x[2];
#pragma unroll
            for (int kb = 0; kb < 2; ++kb)
#pragma unroll
                for (int i = 0; i < 16; ++i) x[kb][i] = 0.f;
            const int kofs = DK == 32 ? 32 * s : 0;
#pragma unroll
            for (int ks = 0; ks < NKS; ++ks) {
                const bf16x8 a0 = *(const bf16x8*)(kb_ + r * 72 + kofs + 16 * ks + 8 * h), a1 = *(const bf16x8*)(kb_ + (32 + r) * 72 + kofs + 16 * ks + 8 * h);
                const bf16x8 qv = *(const bf16x8*)(sQ + ((s * NKS + ks) * 64 + lane) * 8);
                x[0] = MFMA32(a0, qv, x[0]); x[1] = MFMA32(a1, qv, x[1]);
            }
            float mx = x[0][0];
#pragma unroll
            for (int i = 1; i < 16; ++i) mx = fmaxf(mx, x[0][i]);
#pragma unroll
            for (int i = 0; i < 16; ++i) mx = fmaxf(mx, x[1][i]);
            mx = fmaxf(mx, shx(mx, lane, 32));
            if (__builtin_amdgcn_ballot_w64(mx > m_[s] + 8.f) != 0) {
                const float mn = fmaxf(m_[s], mx);
                const float al = __builtin_amdgcn_exp2f(m_[s] - mn);
                m_[s] = mn;
                l_[s] *= al;
#pragma unroll
                for (int d = 0; d < 2; ++d)
#pragma unroll
                    for (int i = 0; i < 16; ++i) O[s][d][i] *= al;
            }
            const f32x2 mref = {m_[s], m_[s]};
            float ps = 0.f;
#pragma unroll
            for (int kb = 0; kb < 2; ++kb)
#pragma unroll
                for (int i2 = 0; i2 < 8; ++i2) {
                    f32x2 t = {x[kb][2 * i2], x[kb][2 * i2 + 1]};
                    asm("v_pk_add_f32 %0, %1, %2 neg_lo:[0,1] neg_hi:[0,1]" : "=v"(t) : "v"(t), "v"(mref));
                    const float e0 = __builtin_amdgcn_exp2f(t.x), e1 = __builtin_amdgcn_exp2f(t.y);
                    x[kb][2 * i2] = e0; x[kb][2 * i2 + 1] = e1; ps += e0 + e1;
                }
            l_[s] += ps;
#pragma unroll
            for (int kb = 0; kb < 2; ++kb)
#pragma unroll
                for (int st = 0; st < 2; ++st) {
                    u32x4 w;
                    w.x = pk_bf16(x[kb][8 * st], x[kb][8 * st + 1]); w.y = pk_bf16(x[kb][8 * st + 2], x[kb][8 * st + 3]);
                    w.z = pk_bf16(x[kb][8 * st + 4], x[kb][8 * st + 5]); w.w = pk_bf16(x[kb][8 * st + 6], x[kb][8 * st + 7]);
                    const bf16x8 pfr = __builtin_bit_cast(bf16x8, w);
#pragma unroll
                    for (int d = 0; d < 2; ++d) {
                        const bf16_t* vp = vb_ + (32 * d + r) * 68 + 32 * kb + 16 * st + 4 * h;
                        const s16x4 lo = *(const s16x4*)vp, hi = *(const s16x4*)(vp + 8);
                        const bf16x8 vf = __builtin_shufflevector(lo, hi, 0, 1, 2, 3, 4, 5, 6, 7);
                        O[s][d] = MFMA32(vf, pfr, O[s][d]);
                    }
                }
        }
        if (kt + 1 < nkt) {
            bf16_t* wk = sK + (cur ^ 1) * 64 * 72; bf16_t* wv = sV + (cur ^ 1) * 64 * 68;
#pragma unroll
            for (int i = 0; i < 2; ++i) {
                *(u32x4*)(wk + (srow + 32 * i) * 72 + sc8) = rk[i];
                *(u32x2*)(wv + (srow + 32 * i) * 68 + sc8) = (u32x2){rv[i].x, rv[i].y}; *(u32x2*)(wv + (srow + 32 * i) * 68 + sc8 + 4) = (u32x2){rv[i].z, rv[i].w};
            }
        }
        __syncthreads();
    }
    const float inv0 = 1.f / (l_[0] + shx(l_[0], lane, 32)), inv1 = 1.f / (l_[1] + shx(l_[1], lane, 32));
    bf16_t* orow = p.H + prow * DM;
    if (DK == 32) {
        const float lam = p.LAM[layer];
        const float lam_init = layer == 0 ? 0.2f : 0.35550906759096926f;
        float ss = 0.f;
#pragma unroll
        for (int d = 0; d < 2; ++d)
#pragma unroll
            for (int i = 0; i < 16; ++i) { const float o = O[0][d][i] * inv0 - lam * O[1][d][i] * inv1; O[0][d][i] = o; ss += o * o; }
        ss += shx(ss, lane, 32);
        const float rs = rsqrtf(ss * (1.f / 64.f) + EPSV) * (1.f - lam_init);
        const float* gn = p.diff_norm_g + layer * 256 + hd * 64;
        float gnv[2][16];
#pragma unroll
        for (int d = 0; d < 2; ++d)
#pragma unroll
            for (int i = 0; i < 16; ++i) gnv[d][i] = gn[32 * d + crow(i, h)];
#pragma unroll
        for (int d = 0; d < 2; ++d)
#pragma unroll
            for (int ig = 0; ig < 4; ++ig) {
                const int dv = 32 * d + 8 * ig + 4 * h;
                u32x2 w;
                w.x = pk_bf16(O[0][d][4 * ig] * rs * gnv[d][4 * ig], O[0][d][4 * ig + 1] * rs * gnv[d][4 * ig + 1]);
                w.y = pk_bf16(O[0][d][4 * ig + 2] * rs * gnv[d][4 * ig + 2], O[0][d][4 * ig + 3] * rs * gnv[d][4 * ig + 3]);
                *(u32x2*)(orow + hd * 64 + dv) = w;
            }
    } else {
#pragma unroll
        for (int s = 0; s < 2; ++s) {
            const float inv = s == 0 ? inv0 : inv1;
#pragma unroll
            for (int d = 0; d < 2; ++d)
#pragma unroll
                for (int ig = 0; ig < 4; ++ig) {
                    const int dv = 32 * d + 8 * ig + 4 * h;
                    u32x2 w;
                    w.x = pk_bf16(O[s][d][4 * ig] * inv, O[s][d][4 * ig + 1] * inv);
                    w.y = pk_bf16(O[s][d][4 * ig + 2] * inv, O[s][d][4 * ig + 3] * inv);
                    *(u32x2*)(orow + 768 + hd * 128 + s * 64 + dv) = w;
                }
        }
    }
}

constexpr int NPHASE = 2 + 12 * 2;
typedef const Params __attribute__((address_space(4)))* KParams;
DI void run_phase(int ph, char* smem) {
    KParams kp = (KParams)__builtin_amdgcn_kernarg_segment_ptr();
    asm volatile("" : "+s"(kp));
#if defined(__HIP_DEVICE_COMPILE__)
    const Params p = *kp;
#else
    const Params p{};
#endif
    const int bid = obid(), G = ogrid();
    char* smh = smem + ohalf() * HALF_LDS;
    if (ph == 0) { phase_prologue(p, smh); return; }
    if (ph == 1) { ln_phase(p, 0, nullptr, nullptr, p.MOD, 0, NT); return; }
    const int l = (ph - 2) / 12, q = (ph - 2) % 12;
    const bool last = l == 1;
    const float* modl = p.MOD + (size_t)l * 9 * 9216;
    const bf16_t* wb = p.WB + (size_t)l * W_LAYER;
    const int mt_post = last ? NL / 256 : NT / 256;
    if (q == 0 || q == 9) {
        EpiSwiglu e{p.ACT};
        gemm_phase(p.H, wb + (q == 0 ? W_WI1 : W_WI2), 1024, q == 0 ? NT / 256 : mt_post, 22, e, smem);
    } else if (q == 1 || q == 10 || q == 7) {
        const int pl = q == 1 ? l - 1 : l, pj = q == 7 ? 0 : (q == 10 ? 1 : 2);
        const int fin = (l == 0 && q == 1) ? 1 : 0;
        const float* pgp = fin ? p.ln_g : p.ln_g + ((size_t)pl * 3 + pj) * 1024; const float* pbp = fin ? p.ln_b : p.ln_b + ((size_t)pl * 3 + pj) * 1024;
        EpiResid e{&p, modl, q == 1 ? 2 : (q == 10 ? 8 : 5), q == 7 ? 1.0f : 0.5f, fin, pgp, pbp};
        const bf16_t* A = q == 7 ? p.H : p.ACT;
        const bf16_t* B = wb + (q == 1 ? W_WO1 : (q == 10 ? W_WO2 : W_WOUT));
        gemm_phase(A, B, q == 7 ? 1024 : DFF, q == 1 ? NT / 256 : mt_post, 4, e, smem);
    } else if (q == 2 || q == 8 || q == 11) {
        const int j = q == 2 ? 0 : (q == 8 ? 1 : 2);
        const float* g = p.ln_g + ((size_t)l * 3 + j) * 1024; const float* bb = p.ln_b + ((size_t)l * 3 + j) * 1024;
        if (q == 11 && last) ln_phase(p, 2, g, bb, modl, 0, NL);
        else if (q == 11) ln_phase(p, 1, g, bb, p.MOD + (size_t)(l + 1) * 9 * 9216, 0, NT);
        else ln_phase(p, 1, g, bb, modl, q == 2 ? 1 : 2, q == 2 ? NT : mt_post * 256);
    } else if (q == 3) {
        EpiProj e{p.ACT, p.GATES, p.ml_gate_b + l * 16};
        gemm_phase(p.H, wb + W_WIN, 1024, NT / 256, PWP / 256, e, smem);
    } else if (q == 4) {
        const int n1 = NB * NCH * 6, n2 = NB * 4 * NCH;
        for (int k = 0; k < (n1 + G - 1) / G; ++k) { int it = bid + k * G; if (it >= n1) it = n1 - 1; prepkv_item(p, l, it, smh); }
        for (int k = 0; k < (n2 + G - 1) / G; ++k) { int it = bid + k * G; if (it >= n2) it = n2 - 1; ml1_item(p, it, smh); }
        const int npl = NB * 128 * 4, npc = last ? 0 : NB * 4 * 4, n3 = npl + npc;
        for (int k = 0; k < (n3 + G - 1) / G; ++k) {
            int it = bid + k * G; if (it >= n3) it = n3 - 1;
            if (it < npl) pool_item(p, l, it >> 9, (it >> 2) & 127, it & 3, smh);
            else { const int i2 = it - npl; pool_item(p, l, 8 + (i2 >> 4), (i2 >> 2) & 3, i2 & 3, smh); }
        }
    } else if (q == 5) {
        for (int it = bid; it < 64 * 9; it += G) scan_item(p, it);
        const int rb_ = rbid(), xcd = rb_ & 7, local = (rb_ >> 3) * 2 + ohalf(), nloc = (rgrid() >> 3) * 2;
        for (int k = 0; k < (384 + nloc - 1) / nloc; ++k) {
            int idx = local + k * nloc; if (idx >= 384) idx = 383;
            const int pair = (idx >> 6) * 8 + xcd, qt = idx & 63, b = pair / 6, hh = pair % 6;
            if (hh < 4) attn_item<32>(p, l, b, hh, qt, 0, smh); else attn_item<64>(p, l, b, hh - 4, qt, 0, smh);
        }
        if (!last) {
            const int n4 = NB * 6 * 2;
            for (int k = 0; k < (n4 + G - 1) / G; ++k) {
                int it = bid + k * G; if (it >= n4) it = n4 - 1;
                const int qt = it & 1, pair = it >> 1, b = pair / 6, hh = pair % 6;
                if (hh < 4) attn_item<32>(p, l, b, hh, qt, 1, smh); else attn_item<64>(p, l, b, hh - 4, qt, 1, smh);
            }
        }
    } else if (q == 6) {
        const int cpc = last ? 128 : NCH, n5 = NB * 4 * cpc, n5p = (n5 + 1) >> 1;
        for (int k = 0; k < (n5p + G - 1) / G; ++k) {
            int it = bid + k * G; if (it >= n5p) it = n5p - 1;
            ml3_pair(p, l, it, cpc, n5, last ? 1 : 0, smh);
        }
    }
}

__global__ void __launch_bounds__(WG_THREADS, 2) fwd_megakernel(Params p, int ph_lo, int ph_hi) {
    extern __shared__ __attribute__((aligned(16))) char smem[];
    __shared__ uint4 xb_words;
    if (threadIdx.x == 0) xb_words = make_uint4(0u, 0u, 0u, 0u);
    __syncthreads();
    const XcdBarrier xb = xcd_barrier_post(p.XBAR, (volatile XB_LAS unsigned*)&xb_words);
    for (int ph = ph_lo; ph < ph_hi; ++ph) {
        run_phase(ph, smem);
        if (ph + 1 < ph_hi) {
            if (ph == ph_lo) cg::this_grid().sync();
            else xcd_barrier(xb);
        }
    }
}

static inline size_t align_up(size_t v) { return (v + 255) & ~(size_t)255; }

extern "C" void kernel_launch(void* const* d_in, const int* in_sizes, int n_in, void* d_out, int out_size, void* d_ws, size_t ws_size, hipStream_t stream) {
    (void)in_sizes; (void)n_in; (void)out_size;
    static int grid_blocks = 0;
    if (!grid_blocks) {
        int dev = 0, cus = 0, per_cu = 0;
        hipGetDevice(&dev);
        hipDeviceGetAttribute(&cus, hipDeviceAttributeMultiprocessorCount, dev);
        if (hipFuncSetAttribute((const void*)fwd_megakernel, hipFuncAttributeMaxDynamicSharedMemorySize, LDS_BYTES) != hipSuccess) fprintf(stderr, "hipFuncSetAttribute failed\n");
        hipOccupancyMaxActiveBlocksPerMultiprocessor(&per_cu, fwd_megakernel, WG_THREADS, LDS_BYTES);
        if (per_cu > 1) per_cu = 1;
        if (per_cu < 1) per_cu = 1;
        grid_blocks = cus * per_cu;
        grid_blocks -= grid_blocks % 8;
    }
    Params p;
    memset(&p, 0, sizeof(p));
    const float* const* in = (const float* const*)d_in;
    p.x = in[0]; p.c = in[1]; p.ctx = in[2]; p.c_ctx = in[3]; p.w_ada = in[4]; p.b_ada = in[5]; p.ln_g = in[6]; p.ln_b = in[7];
    p.ffn1_wi = in[8]; p.ffn1_wo = in[9]; p.ffn2_wi = in[10]; p.ffn2_wo = in[11]; p.w_in = in[12]; p.w_out = in[13];
    p.diff_lambda = in[14]; p.diff_norm_g = in[15]; p.pool_w = in[16]; p.pool_scale = in[17]; p.ml_gate_b = in[18]; p.ml_norm_g = in[19]; p.qng = in[20]; p.kng = in[21];
    p.XL = (float*)d_out;
    char* w = (char*)d_ws; size_t off = 0;
    auto take = [&](size_t bytes) { char* r = w + off; off = align_up(off + bytes); return r; };
    p.WB = (bf16_t*)take(2 * W_LAYER * 2);
    p.MOD = (float*)take((size_t)2 * 9 * 9216 * 4);
    p.ROPEA = (float*)take((size_t)SEQL * 16 * 2 * 4);
    p.ROPED = (float*)take((size_t)SEQL * 32 * 2 * 4);
    p.LAM = (float*)take(256);
    p.XC = (float*)take((size_t)NC * DM * 4);
    p.H = (bf16_t*)take((size_t)NT * DM * 2);
    p.ACT = (bf16_t*)take((size_t)NT * DFF * 2);
    p.GATES = (float*)take((size_t)NT * 16 * 4);
    p.KA = (bf16_t*)take((size_t)NB * 4 * NKEY * 64 * 2);
    p.VTA = (bf16_t*)take((size_t)NB * 4 * NKEY * 64 * 2);
    p.KD = (bf16_t*)take((size_t)NB * 2 * NKEY * 64 * 2);
    p.VTD = (bf16_t*)take((size_t)NB * 2 * NKEY * 64 * 2);
    p.ST = (bf16_t*)take((size_t)NB * 4 * 2 * NCH * STSZ * 2);
    p.DEC = (float*)take((size_t)NB * 4 * 2 * NCH * 4);
    p.SYNC = (unsigned*)take(4096);
    p.STATS = (float*)take((size_t)NT * 2 * 4);
    p.XBAR = (unsigned*)take((size_t)XCD_BAR_WORDS * 4);
    if (off > ws_size) { fprintf(stderr, "workspace too small: need %zu have %zu\n", off, ws_size); return; }
#if MK_SPLIT
    for (int ph = 0; ph < NPHASE; ++ph) hipLaunchKernelGGL(fwd_megakernel, dim3(grid_blocks), dim3(WG_THREADS), LDS_BYTES, stream, p, ph, ph + 1);
#else
    (void)hipMemsetAsync(p.XBAR, 0, (size_t)XCD_BAR_WORDS * 4, stream);
    int lo = 0, hi = NPHASE;
    void* args[] = {&p, &lo, &hi};
    hipError_t e = hipLaunchCooperativeKernel((const void*)fwd_megakernel, dim3(grid_blocks), dim3(WG_THREADS), args, LDS_BYTES, stream);
    if (e != hipSuccess) fprintf(stderr, "cooperative launch failed: %s (grid %d)\n", hipGetErrorString(e), grid_blocks);
#endif
}
```
